# Optimizing an MI355X kernel written in HIP

```python
import math
import jax, jax.numpy as jnp
from jax import lax
import numpy as np

D_MODEL = 1024
BATCH = 1
SEQ = 16384
DEPTH = 1

GRID_W = 64
WIN_H = 8
WIN_W = 16
NA_HEADS = 8
NA_HEAD_DIM = 64
NA_WIDTH = NA_HEADS * NA_HEAD_DIM
SG_GROUPS = 4
SG_GROUP_DIM = 128
SG_WIDTH = SG_GROUPS * SG_GROUP_DIM
SG_CHUNK = 128
IN_COLS = 3 * NA_WIDTH + 2 * SG_WIDTH + 2 * D_MODEL
PEER_HEADS = 8
PEER_N_KEYS = 128
PEER_N_EXPERTS = PEER_N_KEYS * PEER_N_KEYS
PEER_KEY_DIM = 256
PEER_HALF = PEER_KEY_DIM // 2
PEER_TOPK = 16
PEER_BLOCK = 128
DN_ALPHA = (2 * DEPTH) ** 0.25
DN_BETA = (8 * DEPTH) ** -0.25
LN_EPS = 1e-5

kernel_name = "hybrid_natten_sgu_peer_deepnorm"


def layer_norm(x, g, b):
    xf = x.astype(jnp.float32)
    mu = jnp.mean(xf, axis=-1, keepdims=True)
    xc = xf - mu
    var = jnp.mean(xc * xc, axis=-1, keepdims=True)
    y = xc * lax.rsqrt(var + LN_EPS)
    return (y * g.astype(jnp.float32) + b.astype(jnp.float32)).astype(x.dtype)


def neighbourhood_attention(q, k, v, rpb):
    b, s, h, dh = q.shape
    rows = s // GRID_W
    kh = min(WIN_H, rows)
    kw = WIN_W
    qg = q.reshape(b, rows, GRID_W, h, dh)
    kg = k.reshape(b, rows, GRID_W, h, dh)
    vg = v.reshape(b, rows, GRID_W, h, dh)
    cols = np.arange(GRID_W)
    col_start = np.clip(cols - kw // 2, 0, GRID_W - kw)
    col_idx = col_start[:, None] + np.arange(kw)[None, :]
    dc = col_idx - cols[:, None] + (WIN_W - 1)
    scale = dh ** -0.5

    def row_block(r):
        rs = jnp.clip(r - kh // 2, 0, rows - kh)
        q_r = lax.dynamic_index_in_dim(qg, r, axis=1, keepdims=False)
        k_r = lax.dynamic_slice_in_dim(kg, rs, kh, axis=1)[:, :, col_idx]
        v_r = lax.dynamic_slice_in_dim(vg, rs, kh, axis=1)[:, :, col_idx]
        dr = rs + jnp.arange(kh) - r + (WIN_H - 1)
        bias = rpb[:, dr[None, :, None], dc[:, None, :]]
        logits = jnp.einsum('bqhd,bkqwhd->bhqkw', q_r, k_r).astype(jnp.float32) * scale
        logits = logits + bias.astype(jnp.float32)[None]
        p = jax.nn.softmax(logits.reshape(b, h, GRID_W, kh * kw), axis=-1)
        p = p.reshape(b, h, GRID_W, kh, kw).astype(v.dtype)
        return jnp.einsum('bhqkw,bkqwhd->bqhd', p, v_r)

    out = lax.map(row_block, jnp.arange(rows))
    return out.transpose(1, 0, 2, 3, 4).reshape(b, s, h * dh)


def spatial_gating(u, v, norm_g, norm_b, w_s, b_s):
    b, s, _ = u.shape
    n = s // SG_CHUNK
    v = layer_norm(v, norm_g, norm_b)
    vc = v.reshape(b, n, SG_CHUNK, SG_GROUPS, SG_GROUP_DIM)
    mixed = jnp.einsum('gpq,bnqgc->bnpgc', w_s, vc) + b_s.T[None, None, :, :, None]
    return u * mixed.reshape(b, s, SG_WIDTH)


def peer_layer(x, wq, subkeys1, subkeys2, u_tab, v_tab):
    b, s, d = x.shape
    xb = x.reshape(b * s // PEER_BLOCK, PEER_BLOCK, d)

    def block(xt):
        q = (xt @ wq).reshape(PEER_BLOCK, PEER_HEADS, PEER_KEY_DIM)
        s1 = jnp.einsum('thd,nd->thn', q[..., :PEER_HALF], subkeys1).astype(jnp.float32)
        s2 = jnp.einsum('thd,nd->thn', q[..., PEER_HALF:], subkeys2).astype(jnp.float32)
        v1, i1 = lax.top_k(s1, PEER_TOPK)
        v2, i2 = lax.top_k(s2, PEER_TOPK)
        cand = (v1[..., :, None] + v2[..., None, :]).reshape(PEER_BLOCK, PEER_HEADS, PEER_TOPK * PEER_TOPK)
        vals, pos = lax.top_k(cand, PEER_TOPK)
        e1 = jnp.take_along_axis(i1, pos // PEER_TOPK, axis=-1)
        e2 = jnp.take_along_axis(i2, pos % PEER_TOPK, axis=-1)
        ids = e1 * PEER_N_KEYS + e2
        g = jax.nn.softmax(vals, axis=-1)
        a = jnp.einsum('td,thkd->thk', xt, u_tab[ids])
        hid = (jax.nn.gelu(a.astype(jnp.float32)) * g).astype(xt.dtype)
        return jnp.einsum('thk,thkd->td', hid, v_tab[ids])

    return lax.map(block, xb).reshape(b, s, d)


def setup_inputs(seed: int = 0) -> dict:
    key = jax.random.key(seed)
    ks = jax.random.split(key, 20)
    f32 = jnp.float32
    nrm = lambda k, shp, sc: jax.random.normal(k, shp, f32) * sc
    L = DEPTH
    return {
        "x": nrm(ks[0], (BATCH, SEQ, D_MODEL), 1.0),
        "w_in": nrm(ks[1], (L, D_MODEL, IN_COLS), D_MODEL ** -0.5),
        "na_rpb": nrm(ks[2], (L, NA_HEADS, 2 * WIN_H - 1, 2 * WIN_W - 1), 0.1),
        "sg_norm_g": 1.0 + nrm(ks[3], (L, SG_WIDTH), 0.02),
        "sg_norm_b": nrm(ks[4], (L, SG_WIDTH), 0.02),
        "sg_spatial_w": nrm(ks[5], (L, SG_GROUPS, SG_CHUNK, SG_CHUNK), SG_CHUNK ** -0.5),
        "sg_spatial_b": 1.0 + nrm(ks[6], (L, SG_GROUPS, SG_CHUNK), 0.02),
        "w_branch_na": nrm(ks[7], (L, NA_WIDTH, D_MODEL), NA_WIDTH ** -0.5),
        "w_branch_sg": nrm(ks[8], (L, SG_WIDTH, D_MODEL), SG_WIDTH ** -0.5),
        "w_out": nrm(ks[9], (L, D_MODEL, D_MODEL), DN_BETA * D_MODEL ** -0.5),
        "ln1_g": 1.0 + nrm(ks[10], (L, D_MODEL), 0.02),
        "ln1_b": nrm(ks[11], (L, D_MODEL), 0.02),
        "peer_wq": nrm(ks[12], (L, D_MODEL, PEER_HEADS * PEER_KEY_DIM), D_MODEL ** -0.5),
        "peer_subkeys1": nrm(ks[13], (L, PEER_N_KEYS, PEER_HALF), PEER_HALF ** -0.5),
        "peer_subkeys2": nrm(ks[14], (L, PEER_N_KEYS, PEER_HALF), PEER_HALF ** -0.5),
        "peer_u": nrm(ks[15], (L, PEER_N_EXPERTS, D_MODEL), D_MODEL ** -0.5),
        "peer_v": nrm(ks[16], (L, PEER_N_EXPERTS, D_MODEL), DN_BETA),
        "ln2_g": 1.0 + nrm(ks[17], (L, D_MODEL), 0.02),
        "ln2_b": nrm(ks[18], (L, D_MODEL), 0.02),
    }


def reference(x, w_in, na_rpb, sg_norm_g, sg_norm_b, sg_spatial_w, sg_spatial_b,
              w_branch_na, w_branch_sg, w_out, ln1_g, ln1_b, peer_wq, peer_subkeys1,
              peer_subkeys2, peer_u, peer_v, ln2_g, ln2_b):
    b, s, _ = x.shape
    splits = np.cumsum([NA_WIDTH, NA_WIDTH, NA_WIDTH, SG_WIDTH, SG_WIDTH, D_MODEL]).tolist()
    for l in range(DEPTH):
        proj = x @ w_in[l]
        q, k, v, su, sv, ga, gb = jnp.split(proj, splits, axis=-1)
        hd = (b, s, NA_HEADS, NA_HEAD_DIM)
        y_na = neighbourhood_attention(q.reshape(hd), k.reshape(hd), v.reshape(hd), na_rpb[l])
        y_sg = spatial_gating(jax.nn.gelu(su), jax.nn.gelu(sv), sg_norm_g[l], sg_norm_b[l],
                              sg_spatial_w[l], sg_spatial_b[l])
        merged = jax.nn.sigmoid(ga) * (y_na @ w_branch_na[l]) + jax.nn.sigmoid(gb) * (y_sg @ w_branch_sg[l])
        x = layer_norm(DN_ALPHA * x + merged @ w_out[l], ln1_g[l], ln1_b[l])
        y_peer = peer_layer(x, peer_wq[l], peer_subkeys1[l], peer_subkeys2[l], peer_u[l], peer_v[l])
        x = layer_norm(DN_ALPHA * x + y_peer, ln2_g[l], ln2_b[l])
    return x
```

```cpp
#include <hip/hip_runtime.h>
#include <hip/hip_cooperative_groups.h>
#include <cstdio>
#include <cstdint>
namespace cg = cooperative_groups;
#define MK_N_LAUNCHES 1
namespace pg8 {
#define PG8_LAS __attribute__((address_space(3)))
typedef unsigned short bf16_t;
typedef short bf16x8 __attribute__((ext_vector_type(8)));
typedef float f32x4 __attribute__((ext_vector_type(4)));
typedef unsigned u32x4 __attribute__((ext_vector_type(4)));
constexpr int BM = 256, BK = 64, HALF = 128, HTB = HALF * BK * 2  , STAGE_BYTES = 8 * HTB, NXCD = 8, WGM = 8;

__host__ __device__ __forceinline__ int lds_byte(int r, int c) { const int st = (r >> 4) * 2 + (c >> 5), rr = r & 15, cc = c & 31, ob = rr * 64 + cc * 2; return st * 1024 + (ob ^ (((ob >> 9) & 1) << 5)); }
__host__ __device__ __forceinline__ void stage_rc(int b, int& R, int& C) { const int st = b / 1024, sb = b % 1024, swz = sb ^ (((sb >> 9) & 1) << 5); R = (st >> 1) * 16 + swz / 64; C = (st & 1) * 32 + (swz % 64) / 2; }
__host__ __device__ __forceinline__ int perm32(int rho) { const int n = rho >> 4, i = rho & 15; return 8 * (i >> 2) + 4 * n + (i & 3); }

struct Unit { int pm, pn; };
struct Gemm { const bf16_t* A; const bf16_t* Bt; int M, N, K; };

struct StaticOrder {
    int nM, nN, nwg, G, c;
    __host__ __device__ void init(int M, int N, int G_, int c_) { nM = M / BM; nN = N / BM; nwg = nM * nN; G = G_; c = c_; }
    __host__ __device__ bool next(int i, Unit& u) const {
        const long L = (long)i * G + c; if (L >= nwg) return false;
        int wgid = (int)L; { const int q = nwg / NXCD, r = nwg % NXCD, xcd = wgid % NXCD, off = wgid / NXCD; wgid = (xcd < r ? xcd * (q + 1) : r * (q + 1) + (xcd - r) * q) + off; }
        const int nig = WGM * nN, gid = wgid / nig, fm = gid * WGM, gsz = (nM - fm) < WGM ? (nM - fm) : WGM;
        u.pm = fm + ((wgid % nig) % gsz); u.pn = (wgid % nig) / gsz; return true;
    }
    __device__ __forceinline__ void a_ready(const Unit&) const {}
    __device__ __forceinline__ void done(const Unit&) const {}
};

__device__ __forceinline__ unsigned cvt_pk_bf16(float lo, float hi) { unsigned r; asm volatile("v_cvt_pk_bf16_f32 %0, %1, %2" : "=v"(r) : "v"(lo), "v"(hi)); return r; }
template <class Epi, class Sched, bool ALIGN_EPI = false, bool SP2 = false>
__device__ __forceinline__ void gemm_phase(PG8_LAS unsigned char* lds, const Gemm g, const Sched& S, const Epi& E) {
    const int tid = threadIdx.x, wid = __builtin_amdgcn_readfirstlane(tid >> 6), lane = tid & 63, wr = wid >> 2, wc = wid & 3, fr = lane & 15, fq = lane >> 4;
    const int K = g.K, nt = K / BK;
    unsigned voffA[2], voffB[2];
#pragma unroll
    for (int i = 0; i < 2; ++i) { int R, C; stage_rc(tid * 16 + i * 8192, R, C); const int Rb = Epi::PERM ? ((R & ~31) + perm32(R & 31)) : R;
        voffA[i] = (unsigned)(R * K + C) * 2u; voffB[i] = (unsigned)(Rb * K + C) * 2u; }
    const size_t kstep = (size_t)(BK * 2);
    const size_t hstep = (size_t)HALF * K * 2;
    const size_t tstep = 2 * hstep;
    const unsigned ldsw = (unsigned)wid * 1024u;
    const int aoff = lds_byte(wr * 64 + fr, fq * 8), boff = lds_byte(wc * 32 + fr, fq * 8);
#define PG8_SA(b, h) (((b) * 2 + (h)) * HTB)
#define PG8_SB(b, h) ((4 + (b) * 2 + (h)) * HTB)
#define PG8_STAGE(bufoff, gbase, voff) do { _Pragma("unroll") for (int _i = 0; _i < 2; ++_i) \
        __builtin_amdgcn_global_load_lds((const unsigned*)((const char*)(gbase) + (voff)[_i]), (PG8_LAS unsigned*)(lds + (bufoff) + ldsw + _i * 8192), 16, 0, 0); } while (0)
#define PG8_LDA(dst, b, h) do { _Pragma("unroll") for (int m = 0; m < 4; ++m) _Pragma("unroll") for (int k = 0; k < 2; ++k) dst[m][k] = *(const PG8_LAS bf16x8*)(lds + PG8_SA(b, h) + aoff + m * 2048 + k * 1024); } while (0)
#define PG8_LDB(dst, b, h) do { _Pragma("unroll") for (int n = 0; n < 2; ++n) _Pragma("unroll") for (int k = 0; k < 2; ++k) dst[n][k] = *(const PG8_LAS bf16x8*)(lds + PG8_SB(b, h) + boff + n * 2048 + k * 1024); } while (0)
#define PG8_MMA(ai, bj, At, Bt) do { __builtin_amdgcn_s_setprio(1); _Pragma("unroll") for (int m = 0; m < 4; ++m) _Pragma("unroll") for (int n = 0; n < 2; ++n) _Pragma("unroll") for (int k = 0; k < 2; ++k) \
        acc[ai][bj][m][n] = __builtin_amdgcn_mfma_f32_16x16x32_bf16(Bt[n][k], At[m][k], acc[ai][bj][m][n], 0, 0, 0); __builtin_amdgcn_s_setprio(0); } while (0)
#define PG8_WAIT_V(n) asm volatile("s_waitcnt vmcnt(" #n ")" ::: "memory")
#define PG8_WAIT_L(n) asm volatile("s_waitcnt lgkmcnt(" #n ")" ::: "memory")
#define PG8_BAR __builtin_amdgcn_s_barrier()
#define PG8_SCHED __builtin_amdgcn_sched_barrier(0)
    Unit cur, nxt; int ui = 0;
    if (!S.next(0, cur)) return;
    f32x4 acc[2][2][4][2];
#pragma unroll
    for (int a = 0; a < 2; ++a)
#pragma unroll
        for (int b = 0; b < 2; ++b)
#pragma unroll
            for (int m = 0; m < 4; ++m)
#pragma unroll
                for (int n = 0; n < 2; ++n) acc[a][b][m][n] = (f32x4){0.f, 0.f, 0.f, 0.f};
    bf16x8 At[4][2], B0[2][2], B1[2][2];
    const char* cA = (const char*)g.A + (size_t)cur.pm * tstep; const char* cB = (const char*)g.Bt + (size_t)cur.pn * tstep;
    S.a_ready(cur);
    if constexpr (SP2) {
        PG8_STAGE(PG8_SB(0, 0), cB, voffB); PG8_STAGE(PG8_SB(0, 1), cB + hstep, voffB); PG8_STAGE(PG8_SA(0, 0), cA, voffA); PG8_STAGE(PG8_SA(0, 1), cA + hstep, voffA);
        if (wr == 1) PG8_BAR;
        PG8_WAIT_V(2); PG8_BAR;
        PG8_STAGE(PG8_SB(1, 0), cB + kstep, voffB); PG8_STAGE(PG8_SA(1, 0), cA + kstep, voffA); PG8_STAGE(PG8_SB(1, 1), cB + hstep + kstep, voffB);
        PG8_WAIT_V(6); PG8_BAR;
    } else {
        PG8_STAGE(PG8_SB(0, 0), cB, voffB); PG8_STAGE(PG8_SA(0, 0), cA, voffA); PG8_STAGE(PG8_SB(0, 1), cB + hstep, voffB); PG8_STAGE(PG8_SA(0, 1), cA + hstep, voffA);
        if (wr == 1) PG8_BAR;
        PG8_WAIT_V(4); PG8_BAR;
        PG8_STAGE(PG8_SB(1, 0), cB + kstep, voffB); PG8_STAGE(PG8_SA(1, 0), cA + kstep, voffA); PG8_STAGE(PG8_SB(1, 1), cB + hstep + kstep, voffB);
        PG8_WAIT_V(6); PG8_BAR;
    }
    for (;;) {
        const bool has_next = S.next(ui + 1, nxt);
        const char* nA = has_next ? (const char*)g.A + (size_t)nxt.pm * tstep : cA; const char* nB = has_next ? (const char*)g.Bt + (size_t)nxt.pn * tstep : cB;
        for (int t = 0; t < nt; t += 2) {
            const bool last = (t == nt - 2);
            if constexpr (Epi::HAS_MID) { if (t == (nt >> 1)) E.mid(acc, cur, wr, wc, fr, fq); }
            const char* a1 = cA + (size_t)(t + 1) * kstep;
            const char* a2 = last ? nA : cA + (size_t)(t + 2) * kstep; const char* b2 = last ? nB : cB + (size_t)(t + 2) * kstep;
            const char* a3 = a2 + kstep; const char* b3 = b2 + kstep;
            if (last && has_next) S.a_ready(nxt);
            if constexpr (SP2) {
            PG8_LDB(B0, 0, 0); PG8_LDB(B1, 0, 1); PG8_SCHED; PG8_LDA(At, 0, 0); PG8_STAGE(PG8_SA(1, 1), a1 + hstep, voffA);
            PG8_WAIT_V(8); PG8_WAIT_L(0); PG8_BAR; PG8_MMA(0, 0, At, B0); PG8_MMA(0, 1, At, B1); PG8_BAR; PG8_SCHED;
            PG8_LDA(At, 0, 1); PG8_STAGE(PG8_SB(0, 0), b2, voffB); PG8_STAGE(PG8_SB(0, 1), b2 + hstep, voffB); PG8_STAGE(PG8_SA(0, 0), a2, voffA);
            PG8_WAIT_V(8); PG8_WAIT_L(0); PG8_BAR; PG8_MMA(1, 0, At, B0); PG8_MMA(1, 1, At, B1); PG8_BAR; PG8_SCHED;
            PG8_LDB(B0, 1, 0); PG8_LDB(B1, 1, 1); PG8_SCHED; PG8_LDA(At, 1, 0); PG8_STAGE(PG8_SA(0, 1), a2 + hstep, voffA);
            PG8_WAIT_V(8); PG8_WAIT_L(0); PG8_BAR; PG8_MMA(0, 0, At, B0); PG8_MMA(0, 1, At, B1); PG8_BAR; PG8_SCHED;
            PG8_LDA(At, 1, 1); PG8_STAGE(PG8_SB(1, 0), b3, voffB); PG8_STAGE(PG8_SB(1, 1), b3 + hstep, voffB); PG8_STAGE(PG8_SA(1, 0), a3, voffA);
            PG8_WAIT_V(8); PG8_WAIT_L(0); PG8_BAR; PG8_MMA(1, 0, At, B0); PG8_MMA(1, 1, At, B1); PG8_BAR; PG8_SCHED;
            } else {
            PG8_LDB(B0, 0, 0); PG8_SCHED; PG8_LDA(At, 0, 0); PG8_STAGE(PG8_SA(1, 1), a1 + hstep, voffA);
            PG8_WAIT_L(8); PG8_BAR; PG8_WAIT_L(0); PG8_MMA(0, 0, At, B0); PG8_BAR; PG8_SCHED;
            PG8_LDB(B1, 0, 1); PG8_STAGE(PG8_SB(0, 0), b2, voffB);
            PG8_BAR; PG8_WAIT_L(0); PG8_MMA(0, 1, At, B1); PG8_BAR;
            PG8_LDA(At, 0, 1); PG8_STAGE(PG8_SA(0, 0), a2, voffA);
            PG8_BAR; PG8_WAIT_L(0); PG8_MMA(1, 0, At, B0); PG8_BAR; PG8_SCHED;
            PG8_STAGE(PG8_SB(0, 1), b2 + hstep, voffB);
            PG8_WAIT_V(6); PG8_BAR; PG8_MMA(1, 1, At, B1); PG8_BAR;
            PG8_LDB(B0, 1, 0); PG8_SCHED; PG8_LDA(At, 1, 0); PG8_STAGE(PG8_SA(0, 1), a2 + hstep, voffA);
            PG8_WAIT_L(8); PG8_BAR; PG8_WAIT_L(0); PG8_MMA(0, 0, At, B0); PG8_BAR; PG8_SCHED;
            PG8_LDB(B1, 1, 1); PG8_STAGE(PG8_SB(1, 0), b3, voffB);
            PG8_BAR; PG8_WAIT_L(0); PG8_MMA(0, 1, At, B1); PG8_BAR;
            PG8_LDA(At, 1, 1); PG8_STAGE(PG8_SA(1, 0), a3, voffA);
            PG8_BAR; PG8_WAIT_L(0); PG8_MMA(1, 0, At, B0); PG8_BAR; PG8_SCHED;
            PG8_STAGE(PG8_SB(1, 1), b3 + hstep, voffB);
            PG8_WAIT_V(6); PG8_BAR; PG8_MMA(1, 1, At, B1); PG8_BAR;
            }
        }
        if constexpr (ALIGN_EPI) { if (wr == 0) PG8_BAR; }
        if constexpr (!Epi::AFTER_DRAIN) { E(acc, cur, wr, wc, fr, fq); S.done(cur); }
        if (!has_next) break;
#pragma unroll
        for (int a = 0; a < 2; ++a)
#pragma unroll
            for (int b = 0; b < 2; ++b)
#pragma unroll
                for (int m = 0; m < 4; ++m)
#pragma unroll
                    for (int n = 0; n < 2; ++n) acc[a][b][m][n] = (f32x4){0.f, 0.f, 0.f, 0.f};
        cur = nxt; cA = nA; cB = nB; ++ui;
        if constexpr (ALIGN_EPI) { if (wr == 1) PG8_BAR; }
    }
    PG8_WAIT_V(0);
    if constexpr (!ALIGN_EPI) { if (wr == 0) PG8_BAR; }
    PG8_BAR;
    if constexpr (Epi::AFTER_DRAIN) { E.fused(acc, cur, wr, wc, fr, fq, lds, wid, lane); S.done(cur); }
#undef PG8_SA
#undef PG8_SB
#undef PG8_STAGE
#undef PG8_LDA
#undef PG8_LDB
#undef PG8_MMA
#undef PG8_WAIT_V
#undef PG8_WAIT_L
#undef PG8_BAR
#undef PG8_SCHED
}
}
constexpr int NWAVES = 8;
constexpr int M = 16384, D = 1024, INC = 4608;
constexpr int GRID_W = 64, NROWS = 256;
constexpr int C_Q = 0, C_K = 512, C_V = 1024, C_SU = 1536, C_SV = 2048, C_GA = 2560, C_GB = 3584;
constexpr int NEXP = 16384;
constexpr float LN_EPS = 1e-5f;
constexpr float DN_ALPHA = 1.189207115002721f;
constexpr float LOG2E = 1.4426950408889634f;
constexpr float QSCALE = 0.125f * LOG2E;

constexpr size_t MiB = 1u << 20;
constexpr size_t WS_CTL = 0, CTL_ZERO_BYTES = 64 * 1024;
constexpr size_t WS_WIN = 1 * MiB;
constexpr size_t WS_WCAT = 10 * MiB;
constexpr size_t WS_WOUT = 12 * MiB;
constexpr size_t WS_WQ = 14 * MiB;
constexpr size_t WS_SK = 18 * MiB;
constexpr size_t WS_WS = 18 * MiB + 65536;
constexpr size_t WS_XB = 20 * MiB;
constexpr size_t WS_PROJ = 52 * MiB;
constexpr size_t WS_YCAT = 196 * MiB;
constexpr size_t WS_X1B = 52 * MiB;
constexpr size_t WS_UB = 84 * MiB;
constexpr size_t WS_VB = 116 * MiB;
constexpr size_t WS_QP = 148 * MiB;
constexpr size_t WS_IDS = 212 * MiB;
constexpr size_t WS_G = 220 * MiB;
constexpr size_t WS_END = 256 * MiB;

constexpr int RING_BYTES = 131072;
constexpr int LDS_BYTES = 147456;

#define GAS __attribute__((address_space(1)))
#define LAS __attribute__((address_space(3)))
typedef unsigned short bf16;
typedef unsigned v4u __attribute__((ext_vector_type(4)));
typedef unsigned v2u __attribute__((ext_vector_type(2)));
typedef float f32x4 __attribute__((ext_vector_type(4)));
typedef float f32x16 __attribute__((ext_vector_type(16)));
typedef short bf16x8 __attribute__((ext_vector_type(8)));
typedef __bf16 bf2_t __attribute__((ext_vector_type(2)));
typedef float f32x2_t __attribute__((ext_vector_type(2)));

__device__ __forceinline__ unsigned pk2(float lo, float hi) { f32x2_t v = {lo, hi}; bf2_t b = __builtin_convertvector(v, bf2_t); return __builtin_bit_cast(unsigned, b); }
__device__ __forceinline__ float bf_lo(unsigned u) { return __uint_as_float(u << 16); }
__device__ __forceinline__ float bf_hi(unsigned u) { return __uint_as_float(u & 0xffff0000u); }
__device__ __forceinline__ float fexp2(float x) { return __builtin_amdgcn_exp2f(x); }
__device__ __forceinline__ float frcp(float x) { return __builtin_amdgcn_rcpf(x); }
__device__ __forceinline__ float sigmoidf_(float x) { return frcp(1.0f + fexp2(-LOG2E * x)); }
__device__ __forceinline__ float gelu_tanh(float x) { const float z = 1.5957691216057308f * (x + 0.044715f * x * x * x); return x * frcp(1.0f + fexp2(-LOG2E * z)); }
__device__ __forceinline__ float wave_sum(float v) {
#pragma unroll
    for (int o = 1; o < 64; o <<= 1) v += __shfl_xor(v, o);
    return v;
}
__device__ __forceinline__ int crow(int r, int hi) { return (r & 3) + 8 * (r >> 2) + 4 * hi; }
#define MFMA32(a, b, c) __builtin_amdgcn_mfma_f32_32x32x16_bf16((a), (b), (c), 0, 0, 0)
#define LDS_WAIT() asm volatile("s_waitcnt lgkmcnt(0)" ::: "memory")

namespace pg8 {
struct EpiProj {
    static constexpr bool PERM = true, AFTER_DRAIN = false, HAS_MID = false;
    bf16_t* O;
    __device__ __forceinline__ void operator()(const f32x4 (&acc)[2][2][4][2], const Unit& u, int wr, int wc, int fr, int fq) const {
        const int row0 = u.pm * BM + wr * 64 + fr, col0 = u.pn * BM + wc * 32 + 8 * fq;
        const int type = u.pn < 2 ? 0 : (u.pn < 6 ? 1 : (u.pn < 10 ? 2 : 3));
#pragma unroll
        for (int ai = 0; ai < 2; ++ai)
#pragma unroll
            for (int m = 0; m < 4; ++m) { bf16_t* rowp = O + (size_t)(row0 + ai * HALF + m * 16) * INC + col0;
#pragma unroll
                for (int bj = 0; bj < 2; ++bj) { f32x4 v0 = acc[ai][bj][m][0], v1 = acc[ai][bj][m][1];
                    if (type == 0) { v0 = v0 * QSCALE; v1 = v1 * QSCALE; }
                    else if (type == 2) {
#pragma unroll
                        for (int e = 0; e < 4; ++e) { v0[e] = gelu_tanh(v0[e]); v1[e] = gelu_tanh(v1[e]); } }
                    else if (type == 3) {
#pragma unroll
                        for (int e = 0; e < 4; ++e) { v0[e] = sigmoidf_(v0[e]); v1[e] = sigmoidf_(v1[e]); } }
                    u32x4 w; w.x = pk2(v0[0], v0[1]); w.y = pk2(v0[2], v0[3]); w.z = pk2(v1[0], v1[1]); w.w = pk2(v1[2], v1[3]);
                    *(u32x4*)(rowp + bj * HALF) = w; } }
    }
};
struct EpiPlain {
    static constexpr bool PERM = true, AFTER_DRAIN = false, HAS_MID = false;
    bf16_t* O; int ldc;
    __device__ __forceinline__ void operator()(const f32x4 (&acc)[2][2][4][2], const Unit& u, int wr, int wc, int fr, int fq) const {
        const int row0 = u.pm * BM + wr * 64 + fr, col0 = u.pn * BM + wc * 32 + 8 * fq;
#pragma unroll
        for (int ai = 0; ai < 2; ++ai)
#pragma unroll
            for (int m = 0; m < 4; ++m) { bf16_t* rowp = O + (size_t)(row0 + ai * HALF + m * 16) * ldc + col0;
#pragma unroll
                for (int bj = 0; bj < 2; ++bj) { const f32x4 v0 = acc[ai][bj][m][0], v1 = acc[ai][bj][m][1];
                    u32x4 w; w.x = pk2(v0[0], v0[1]); w.y = pk2(v0[2], v0[3]); w.z = pk2(v1[0], v1[1]); w.w = pk2(v1[2], v1[3]);
                    *(u32x4*)(rowp + bj * HALF) = w; } }
    }
};
struct EpiMerge {
    static constexpr bool PERM = true, AFTER_DRAIN = false, HAS_MID = true;
    const bf16_t* SA; const bf16_t* SB; bf16_t* O;
    __device__ __forceinline__ void mid(f32x4 (&acc)[2][2][4][2], const Unit& u, int wr, int wc, int fr, int fq) const {
        int row0 = u.pm * BM + wr * 64 + fr; const int col0 = u.pn * BM + wc * 32 + 8 * fq;
        asm volatile("" : "+v"(row0));
#pragma unroll
        for (int ai = 0; ai < 2; ++ai)
#pragma unroll
            for (int m = 0; m < 4; ++m) { const unsigned off = (unsigned)((row0 + ai * HALF + m * 16) * INC + col0) * 2u;
#pragma unroll
                for (int bj = 0; bj < 2; ++bj) { const u32x4 a = *(const u32x4*)((const char*)SA + off + bj * HALF * 2), b = *(const u32x4*)((const char*)SB + off + bj * HALF * 2);
                    f32x4 r0, r1;
                    r0[0] = bf_lo(a.x) * frcp(bf_lo(b.x)); r0[1] = bf_hi(a.x) * frcp(bf_hi(b.x)); r0[2] = bf_lo(a.y) * frcp(bf_lo(b.y)); r0[3] = bf_hi(a.y) * frcp(bf_hi(b.y));
                    r1[0] = bf_lo(a.z) * frcp(bf_lo(b.z)); r1[1] = bf_hi(a.z) * frcp(bf_hi(b.z)); r1[2] = bf_lo(a.w) * frcp(bf_lo(b.w)); r1[3] = bf_hi(a.w) * frcp(bf_hi(b.w));
                    acc[ai][bj][m][0] = acc[ai][bj][m][0] * r0; acc[ai][bj][m][1] = acc[ai][bj][m][1] * r1; }
                if (m & 1) asm volatile("" ::: "memory"); }
    }
    __device__ __forceinline__ void operator()(const f32x4 (&acc)[2][2][4][2], const Unit& u, int wr, int wc, int fr, int fq) const {
        const int row0 = u.pm * BM + wr * 64 + fr, col0 = u.pn * BM + wc * 32 + 8 * fq;
#pragma unroll
        for (int ai = 0; ai < 2; ++ai)
#pragma unroll
            for (int m = 0; m < 4; ++m) { const int row = row0 + ai * HALF + m * 16;
#pragma unroll
                for (int bj = 0; bj < 2; ++bj) { const u32x4 b = *(const u32x4*)(SB + (size_t)row * INC + col0 + bj * HALF);
                    const f32x4 v0 = acc[ai][bj][m][0], v1 = acc[ai][bj][m][1];
                    u32x4 w; w.x = pk2(v0[0] * bf_lo(b.x), v0[1] * bf_hi(b.x)); w.y = pk2(v0[2] * bf_lo(b.y), v0[3] * bf_hi(b.y));
                    w.z = pk2(v1[0] * bf_lo(b.z), v1[1] * bf_hi(b.z)); w.w = pk2(v1[2] * bf_lo(b.w), v1[3] * bf_hi(b.w));
                    *(u32x4*)(O + (size_t)row * D + col0 + bj * HALF) = w; } }
    }
};
struct EpiResF32 {
    static constexpr bool PERM = false, AFTER_DRAIN = false, HAS_MID = false;
    const float* X; float* O;
    __device__ __forceinline__ void operator()(const f32x4 (&acc)[2][2][4][2], const Unit& u, int wr, int wc, int fr, int fq) const {
        const int row0 = u.pm * BM + wr * 64 + fr, col0 = u.pn * BM + wc * 32 + 4 * fq;
#pragma unroll
        for (int ai = 0; ai < 2; ++ai)
#pragma unroll
            for (int m = 0; m < 4; ++m) { const size_t off = (size_t)(row0 + ai * HALF + m * 16) * D + col0;
#pragma unroll
                for (int bj = 0; bj < 2; ++bj)
#pragma unroll
                    for (int n = 0; n < 2; ++n) { const f32x4 xv = *(const f32x4*)(X + off + bj * HALF + n * 16);
                        *(f32x4*)(O + off + bj * HALF + n * 16) = acc[ai][bj][m][n] + xv * DN_ALPHA; } }
    }
};
}

struct Frame {
    LAS unsigned char* lds;
    int tid, lane, wave, vcu, G;
    float* out;
    unsigned char* ws;
};
struct Args { const float* in[19]; float* out; unsigned char* ws; int ph_lo, ph_hi; };

__device__ __forceinline__ void p0_transpose_item(const float* W, int N, bf16* WT, int ldo, int koff, LAS float* scr, int item, int lane) {
    const int nblk = N / 32, kb = item / nblk, nb = item % nblk, k0 = 64 * kb, n0 = 32 * nb;
#pragma unroll 8
    for (int i = 0; i < 32; ++i) { const int kk = 2 * i + (lane >> 5); scr[kk * 33 + (lane & 31)] = W[(size_t)(k0 + kk) * N + n0 + (lane & 31)]; }
    LDS_WAIT(); asm volatile("" ::: "memory");
    const int c = lane & 7;
#pragma unroll
    for (int j = 0; j < 4; ++j) { const int n = (lane >> 3) + 8 * j; const LAS float* s = scr + (8 * c) * 33 + n;
        v4u o; o.x = pk2(s[0 * 33], s[1 * 33]); o.y = pk2(s[2 * 33], s[3 * 33]); o.z = pk2(s[4 * 33], s[5 * 33]); o.w = pk2(s[6 * 33], s[7 * 33]);
        *(v4u*)(WT + (size_t)(n0 + n) * ldo + koff + k0 + 8 * c) = o; }
    LDS_WAIT(); asm volatile("" ::: "memory");
}
__device__ __forceinline__ void cvt_stream(const float* src, bf16* dst, size_t n8, int gw, int NGW, int lane) {
    for (size_t i = (size_t)gw * 64 + lane; i < n8; i += (size_t)NGW * 64) {
        const f32x4 a = ((const f32x4*)src)[2 * i], b = ((const f32x4*)src)[2 * i + 1];
        v4u o; o.x = pk2(a[0], a[1]); o.y = pk2(a[2], a[3]); o.z = pk2(b[0], b[1]); o.w = pk2(b[2], b[3]);
        ((v4u*)dst)[i] = o; }
}
__device__ __forceinline__ void p0_prologue(Frame& F, const Args& A) {
    LAS float* scr = (LAS float*)(F.lds + F.wave * 16384);
    const int gw = F.vcu * NWAVES + F.wave, NGW = F.G * NWAVES;
    constexpr int I_WIN = (1024 / 64) * (INC / 32), I_BR = (512 / 64) * (1024 / 32), I_OUT = (1024 / 64) * (1024 / 32), I_WQ = (1024 / 64) * (2048 / 32);
    constexpr int NITEMS = I_WIN + 2 * I_BR + I_OUT + I_WQ;
    bf16* WinT = (bf16*)(F.ws + WS_WIN); bf16* WcatT = (bf16*)(F.ws + WS_WCAT); bf16* WoutT = (bf16*)(F.ws + WS_WOUT); bf16* WqT = (bf16*)(F.ws + WS_WQ);
    for (int it = gw; it < NITEMS; it += NGW) {
        int r = it;
        if (r < I_WIN) { p0_transpose_item(A.in[1], INC, WinT, 1024, 0, scr, r, F.lane); continue; } r -= I_WIN;
        if (r < I_BR) { p0_transpose_item(A.in[7], 1024, WcatT, 1024, 0, scr, r, F.lane); continue; } r -= I_BR;
        if (r < I_BR) { p0_transpose_item(A.in[8], 1024, WcatT, 1024, 512, scr, r, F.lane); continue; } r -= I_BR;
        if (r < I_OUT) { p0_transpose_item(A.in[9], 1024, WoutT, 1024, 0, scr, r, F.lane); continue; } r -= I_OUT;
        p0_transpose_item(A.in[12], 2048, WqT, 1024, 0, scr, r, F.lane);
    }
    cvt_stream(A.in[0], (bf16*)(F.ws + WS_XB), (size_t)M * D / 8, gw, NGW, F.lane);
    cvt_stream(A.in[13], (bf16*)(F.ws + WS_SK), 128 * 128 / 8, gw, NGW, F.lane);
    cvt_stream(A.in[14], (bf16*)(F.ws + WS_SK) + 128 * 128, 128 * 128 / 8, gw, NGW, F.lane);
    cvt_stream(A.in[5], (bf16*)(F.ws + WS_WS), 4 * 128 * 128 / 8, gw, NGW, F.lane);
}

__device__ __forceinline__ void na_phase(Frame& F, const Args& A) {
    const bf16* PROJ = (const bf16*)(F.ws + WS_PROJ); bf16* YCAT = (bf16*)(F.ws + WS_YCAT);
    const float* rpb = A.in[2];
    const int lane = F.lane, h = F.wave, q = lane & 31, hi = lane >> 5;
    LAS float* tab = (LAS float*)(F.lds + h * 4096);
    const float NEG = -INFINITY;
    for (int r = F.vcu; r < NROWS; r += F.G) {
        for (int i = lane; i < 15 * 31; i += 64) tab[64 + i] = rpb[h * 465 + i] * LOG2E;
        LDS_WAIT(); asm volatile("" ::: "memory");
        const int rs = min(max(r - 4, 0), NROWS - 8);
        bf16x8 Qf[2][4];
#pragma unroll
        for (int qt = 0; qt < 2; ++qt)
#pragma unroll
            for (int s = 0; s < 4; ++s) Qf[qt][s] = *(const bf16x8*)(PROJ + (size_t)(r * 64 + 32 * qt + q) * INC + C_Q + h * 64 + 16 * s + 8 * hi);
        f32x16 O[2][2];
#pragma unroll
        for (int a = 0; a < 2; ++a)
#pragma unroll
            for (int b = 0; b < 2; ++b)
#pragma unroll
                for (int e = 0; e < 16; ++e) O[a][b][e] = 0.f;
        float mrun[2] = {NEG, NEG}, lsum[2] = {0.f, 0.f};
        int lane_c[2], lane_off[2];
#pragma unroll
        for (int qt = 0; qt < 2; ++qt) { const int qc = 32 * qt + q, cs = min(max(qc - 8, 0), GRID_W - 16); lane_c[qt] = 4 * hi - cs; lane_off[qt] = 4 * hi - qc + 15 + 64; }
        for (int kr = 0; kr < 8; ++kr) {
            const int krow = rs + kr, dr = krow - r + 7;
            const LAS float* tb = tab + dr * 31;
            const bf16* Kb = PROJ + (size_t)(krow * 64) * INC + C_K + h * 64;
            const bf16* Vb = PROJ + (size_t)(krow * 64) * INC + C_V + h * 64;
            f32x16 S[2][2];
#pragma unroll
            for (int kc = 0; kc < 2; ++kc) {
                bf16x8 Kf[4];
#pragma unroll
                for (int s = 0; s < 4; ++s) Kf[s] = *(const bf16x8*)(Kb + (size_t)(32 * kc + q) * INC + 16 * s + 8 * hi);
#pragma unroll
                for (int qt = 0; qt < 2; ++qt) { f32x16 a;
#pragma unroll
                    for (int e = 0; e < 16; ++e) a[e] = 0.f;
#pragma unroll
                    for (int s = 0; s < 4; ++s) a = MFMA32(Kf[s], Qf[qt][s], a);
                    S[qt][kc] = a; }
            }
#pragma unroll
            for (int qt = 0; qt < 2; ++qt) {
                float mx = NEG;
#pragma unroll
                for (int kc = 0; kc < 2; ++kc)
#pragma unroll
                    for (int e = 0; e < 16; ++e) { const int kcc = 32 * kc + crow(e, 0);
                        const bool valid = (unsigned)(kcc + lane_c[qt]) < 16u;
                        const float bsv = tb[kcc + lane_off[qt]];
                        const float v = valid ? S[qt][kc][e] + bsv : NEG;
                        S[qt][kc][e] = v; mx = fmaxf(mx, v); }
                mx = fmaxf(mx, __shfl_xor(mx, 32));
                const float mnew = fmaxf(mrun[qt], mx), alpha = fexp2(mrun[qt] - mnew); mrun[qt] = mnew;
                float ps = 0.f;
#pragma unroll
                for (int kc = 0; kc < 2; ++kc)
#pragma unroll
                    for (int e = 0; e < 16; ++e) { const float p = fexp2(S[qt][kc][e] - mnew); S[qt][kc][e] = p; ps += p; }
                lsum[qt] = lsum[qt] * alpha + ps;
#pragma unroll
                for (int dt = 0; dt < 2; ++dt)
#pragma unroll
                    for (int e = 0; e < 16; ++e) O[dt][qt][e] *= alpha;
            }
#pragma unroll
            for (int kc = 0; kc < 2; ++kc)
#pragma unroll
                for (int s2 = 0; s2 < 2; ++s2) {
                    bf16x8 Pf[2];
#pragma unroll
                    for (int qt = 0; qt < 2; ++qt) { v4u w;
                        w.x = pk2(S[qt][kc][8 * s2 + 0], S[qt][kc][8 * s2 + 1]); w.y = pk2(S[qt][kc][8 * s2 + 2], S[qt][kc][8 * s2 + 3]);
                        w.z = pk2(S[qt][kc][8 * s2 + 4], S[qt][kc][8 * s2 + 5]); w.w = pk2(S[qt][kc][8 * s2 + 6], S[qt][kc][8 * s2 + 7]);
                        Pf[qt] = __builtin_bit_cast(bf16x8, w); }
#pragma unroll
                    for (int dt = 0; dt < 2; ++dt) {
                        bf16x8 Vf;
#pragma unroll
                        for (int j = 0; j < 8; ++j) { const int kk = 16 * s2 + 8 * (j >> 2) + (j & 3);
                            Vf[j] = (short)Vb[(size_t)(32 * kc + kk + 4 * hi) * INC + 32 * dt + q]; }
#pragma unroll
                        for (int qt = 0; qt < 2; ++qt) O[dt][qt] = MFMA32(Vf, Pf[qt], O[dt][qt]);
                    }
                }
        }
#pragma unroll
        for (int qt = 0; qt < 2; ++qt) {
            const float lt = lsum[qt] + __shfl_xor(lsum[qt], 32), inv = 1.0f / lt;
            bf16* orow = YCAT + (size_t)(r * 64 + 32 * qt + q) * D + h * 64;
#pragma unroll
            for (int dt = 0; dt < 2; ++dt)
#pragma unroll
                for (int g4 = 0; g4 < 4; ++g4) { v2u w; w.x = pk2(O[dt][qt][4 * g4 + 0] * inv, O[dt][qt][4 * g4 + 1] * inv); w.y = pk2(O[dt][qt][4 * g4 + 2] * inv, O[dt][qt][4 * g4 + 3] * inv);
                    *(v2u*)(orow + 32 * dt + 8 * g4 + 4 * hi) = w; }
        }
    }
}

__device__ __forceinline__ void sgu_phase(Frame& F, const Args& A) {
    const bf16* PROJ = (const bf16*)(F.ws + WS_PROJ); bf16* YCAT = (bf16*)(F.ws + WS_YCAT);
    const bf16* WsB = (const bf16*)(F.ws + WS_WS);
    const float* gam = A.in[3]; const float* bet = A.in[4]; const float* bsp = A.in[6];
    LAS float* stats = (LAS float*)(F.lds);
    constexpr int VTP = 136;
    LAS bf16* VT = (LAS bf16*)(F.lds + 1024);
    const int tid = F.tid, lane = F.lane, q31 = lane & 31, hi = lane >> 5;
    for (int u = F.vcu; u < 512; u += F.G) {
        const int n = u >> 2, g = u & 3, tok0 = n * 128;
        {
            const int qq = tid >> 2, part = tid & 3;
            const v4u* src = (const v4u*)(PROJ + (size_t)(tok0 + qq) * INC + C_SV + part * 128);
            v4u buf[16];
#pragma unroll
            for (int i = 0; i < 16; ++i) buf[i] = src[i];
            float s = 0.f;
#pragma unroll
            for (int i = 0; i < 16; ++i) s += (bf_lo(buf[i].x) + bf_hi(buf[i].x)) + (bf_lo(buf[i].y) + bf_hi(buf[i].y)) + (bf_lo(buf[i].z) + bf_hi(buf[i].z)) + (bf_lo(buf[i].w) + bf_hi(buf[i].w));
            s += __shfl_xor(s, 1); s += __shfl_xor(s, 2);
            const float mean = s * (1.0f / 512.0f);
            float v2 = 0.f;
#pragma unroll
            for (int i = 0; i < 16; ++i) {
                const unsigned w[4] = {buf[i].x, buf[i].y, buf[i].z, buf[i].w};
#pragma unroll
                for (int e = 0; e < 4; ++e) { const float a = bf_lo(w[e]) - mean, b = bf_hi(w[e]) - mean; v2 += a * a + b * b; } }
            v2 += __shfl_xor(v2, 1); v2 += __shfl_xor(v2, 2);
            if (part == 0) { stats[2 * qq] = mean; stats[2 * qq + 1] = 1.0f / sqrtf(v2 * (1.0f / 512.0f) + LN_EPS); }
        }
        __syncthreads();
        {
            const int qq = tid & 127, cb = __builtin_amdgcn_readfirstlane(tid >> 7), c0 = cb * 32;
            const v4u* src = (const v4u*)(PROJ + (size_t)(tok0 + qq) * INC + C_SV + g * 128 + c0);
            const float mean = stats[2 * qq], rstd = stats[2 * qq + 1];
#pragma unroll
            for (int i = 0; i < 4; ++i) { const v4u b = src[i]; const unsigned w[4] = {b.x, b.y, b.z, b.w};
#pragma unroll
                for (int e = 0; e < 4; ++e) { const int c = c0 + 8 * i + 2 * e;
                    const float y0 = (bf_lo(w[e]) - mean) * rstd * gam[g * 128 + c] + bet[g * 128 + c];
                    const float y1 = (bf_hi(w[e]) - mean) * rstd * gam[g * 128 + c + 1] + bet[g * 128 + c + 1];
                    const unsigned pk = pk2(y0, y1);
                    VT[c * VTP + qq] = (bf16)(pk & 0xffffu); VT[(c + 1) * VTP + qq] = (bf16)(pk >> 16); } }
        }
        __syncthreads();
        const int ct = F.wave >> 1, pt0 = (F.wave & 1) * 2;
        f32x16 acc[2];
#pragma unroll
        for (int i = 0; i < 2; ++i)
#pragma unroll
            for (int e = 0; e < 16; ++e) acc[i][e] = 0.f;
#pragma unroll
        for (int s = 0; s < 8; ++s) {
            const bf16x8 a = *(const LAS bf16x8*)(VT + (ct * 32 + q31) * VTP + 16 * s + 8 * hi);
#pragma unroll
            for (int i = 0; i < 2; ++i) { const bf16x8 b = *(const bf16x8*)(WsB + (size_t)(g * 128 + (pt0 + i) * 32 + q31) * 128 + 16 * s + 8 * hi); acc[i] = MFMA32(a, b, acc[i]); }
        }
#pragma unroll
        for (int i = 0; i < 2; ++i) { const int p = (pt0 + i) * 32 + q31, tok = tok0 + p; const float bsv = bsp[g * 128 + p];
#pragma unroll
            for (int g4 = 0; g4 < 4; ++g4) { const int c = ct * 32 + 8 * g4 + 4 * hi;
                const v2u uu = *(const v2u*)(PROJ + (size_t)tok * INC + C_SU + g * 128 + c);
                v2u w; w.x = pk2(bf_lo(uu.x) * (acc[i][4 * g4 + 0] + bsv), bf_hi(uu.x) * (acc[i][4 * g4 + 1] + bsv));
                w.y = pk2(bf_lo(uu.y) * (acc[i][4 * g4 + 2] + bsv), bf_hi(uu.y) * (acc[i][4 * g4 + 3] + bsv));
                *(v2u*)(YCAT + (size_t)tok * D + 512 + g * 128 + c) = w; } }
        __syncthreads();
    }
}

__device__ __forceinline__ void ln1_phase(Frame& F, const Args& A) {
    const int gw = F.vcu * NWAVES + F.wave, NGW = F.G * NWAVES, lane = F.lane;
    const float* gam = A.in[10]; const float* bet = A.in[11];
    bf16* X1B = (bf16*)(F.ws + WS_X1B);
    for (int m = gw; m < M; m += NGW) {
        f32x4* xr = (f32x4*)(F.out + (size_t)m * D) + lane;
        f32x4 v[4]; float s = 0.f;
#pragma unroll
        for (int j = 0; j < 4; ++j) { v[j] = xr[64 * j]; s += (v[j].x + v[j].y) + (v[j].z + v[j].w); }
        const float mean = wave_sum(s) * (1.f / D); float s2 = 0.f;
#pragma unroll
        for (int j = 0; j < 4; ++j) { v[j] = v[j] - mean; s2 += (v[j].x * v[j].x + v[j].y * v[j].y) + (v[j].z * v[j].z + v[j].w * v[j].w); }
        const float rstd = 1.f / sqrtf(wave_sum(s2) * (1.f / D) + LN_EPS);
        v2u* o8 = (v2u*)(X1B + (size_t)m * D) + lane;
#pragma unroll
        for (int j = 0; j < 4; ++j) { const f32x4 gg = ((const f32x4*)gam)[lane + 64 * j], bb = ((const f32x4*)bet)[lane + 64 * j];
            const f32x4 y = v[j] * rstd * gg + bb; xr[64 * j] = y;
            v2u w; w.x = pk2(y.x, y.y); w.y = pk2(y.z, y.w); o8[64 * j] = w; }
    }
    cvt_stream(A.in[15], (bf16*)(F.ws + WS_UB), (size_t)NEXP * D / 8, gw, NGW, lane);
    cvt_stream(A.in[16], (bf16*)(F.ws + WS_VB), (size_t)NEXP * D / 8, gw, NGW, lane);
}

__device__ __forceinline__ unsigned okey(float v) { const unsigned u = __float_as_uint(v); return (u & 0x80000000u) ? ~u : (u | 0x80000000u); }
__device__ __forceinline__ float okey_inv(unsigned k) { const unsigned u = (k & 0x80000000u) ? (k & 0x7fffffffu) : ~k; return __uint_as_float(u); }
template <int N> __device__ __forceinline__ void bitonic_sort_desc(unsigned (&k)[N]) {
#pragma unroll
    for (int sz = 2; sz <= N; sz <<= 1)
#pragma unroll
        for (int st = sz >> 1; st > 0; st >>= 1)
#pragma unroll
            for (int i = 0; i < N; ++i) { const int l = i ^ st;
                if (l > i) { const unsigned a = k[i], b = k[l]; const unsigned mx = a > b ? a : b, mn = a > b ? b : a;
                    if ((i & sz) == 0) { k[i] = mx; k[l] = mn; } else { k[i] = mn; k[l] = mx; } } }
}
template <int N> __device__ __forceinline__ void bitonic_merge_desc(unsigned (&k)[N]) {
#pragma unroll
    for (int st = N >> 1; st > 0; st >>= 1)
#pragma unroll
        for (int i = 0; i < N; ++i) { const int l = i ^ st;
            if (l > i) { const unsigned a = k[i], b = k[l]; k[i] = a > b ? a : b; k[l] = a > b ? b : a; } }
}
__device__ __forceinline__ void pair_merge16(unsigned (&k)[16]) {
    unsigned c[16];
#pragma unroll
    for (int i = 0; i < 16; ++i) { const unsigned o = (unsigned)__shfl_xor((int)k[15 - i], 32); c[i] = k[i] > o ? k[i] : o; }
    bitonic_merge_desc<16>(c);
#pragma unroll
    for (int i = 0; i < 16; ++i) k[i] = c[i];
}
__device__ __forceinline__ void select_phase(Frame& F, const Args& A) {
    const bf16* QP = (const bf16*)(F.ws + WS_QP); const bf16* SKB = (const bf16*)(F.ws + WS_SK);
    int* IDS = (int*)(F.ws + WS_IDS); float* GG = (float*)(F.ws + WS_G);
    const int gw = F.vcu * NWAVES + F.wave, NGW = F.G * NWAVES, lane = F.lane, q31 = lane & 31, hi = lane >> 5;
    LAS unsigned* slot = (LAS unsigned*)(F.lds + F.wave * (64 * 36) + lane * 36);
    for (int task = gw; task < (M / 32) * 8; task += NGW) {
        const int tb = task >> 3, h = task & 7, tok = tb * 32 + q31;
        unsigned top[2][16];
#pragma unroll
        for (int half = 0; half < 2; ++half) {
            const bf16* qsrc = QP + (size_t)tok * 2048 + h * 256 + half * 128;
            bf16x8 Bq[8];
#pragma unroll
            for (int s = 0; s < 8; ++s) Bq[s] = *(const bf16x8*)(qsrc + 16 * s + 8 * hi);
            const bf16* sk = SKB + half * 16384;
            unsigned key[64];
#pragma unroll
            for (int kt = 0; kt < 4; ++kt) { f32x16 a;
#pragma unroll
                for (int e = 0; e < 16; ++e) a[e] = 0.f;
#pragma unroll
                for (int s = 0; s < 8; ++s) { const bf16x8 af = *(const bf16x8*)(sk + (size_t)(kt * 32 + q31) * 128 + 16 * s + 8 * hi); a = MFMA32(af, Bq[s], a); }
#pragma unroll
                for (int e = 0; e < 16; ++e) { const int idx = kt * 32 + crow(e, 0) + 4 * hi; key[kt * 16 + e] = (okey(a[e]) & ~127u) | (unsigned)(127 - idx); } }
            bitonic_sort_desc<64>(key);
#pragma unroll
            for (int i = 0; i < 16; ++i) top[half][i] = key[i];
            pair_merge16(top[half]);
        }
        float va[16], vb[16];
        unsigned iw[8];
#pragma unroll
        for (int i = 0; i < 16; ++i) { const float v1 = okey_inv(top[0][i] & ~127u), v2 = okey_inv(top[1][i] & ~127u); va[i] = hi ? v2 : v1; vb[i] = hi ? v1 : v2; }
#pragma unroll
        for (int w = 0; w < 4; ++w) { unsigned a = 0, b = 0;
#pragma unroll
            for (int e = 0; e < 4; ++e) { a |= (127u - (top[0][4 * w + e] & 127u)) << (8 * e); b |= (127u - (top[1][4 * w + e] & 127u)) << (8 * e); }
            iw[w] = a; iw[4 + w] = b; }
#pragma unroll
        for (int w = 0; w < 8; ++w) slot[w] = iw[w];
        unsigned cand[32];
        int nc = 0;
#pragma unroll
        for (int i = 0; i < 16; ++i)
#pragma unroll
            for (int j = i; j < 16; ++j) if ((i + 1) * (j + 1) <= 16) {
                const float sum = va[i] + vb[j];
                const unsigned pos = hi ? (unsigned)(j * 16 + i) : (unsigned)(i * 16 + j);
                unsigned kk = (okey(sum) & ~255u) | (255u - pos);
                if (i == j) kk = hi ? 0u : kk;
                cand[nc] = kk; ++nc; }
#pragma unroll
        for (int c = 27; c < 32; ++c) cand[c] = 0u;
        bitonic_sort_desc<32>(cand);
        unsigned fin[16];
#pragma unroll
        for (int i = 0; i < 16; ++i) fin[i] = cand[i];
        pair_merge16(fin);
        LDS_WAIT(); asm volatile("" ::: "memory");
        const LAS unsigned char* sb = (const LAS unsigned char*)slot;
        float vals[16]; int ids[16];
#pragma unroll
        for (int k = 0; k < 16; ++k) { const unsigned pos = 255u - (fin[k] & 255u); vals[k] = okey_inv(fin[k] & ~255u);
            const int e1 = sb[pos >> 4], e2 = sb[16 + (pos & 15)]; ids[k] = e1 * 128 + e2; }
        float den = 0.f, ex[16];
#pragma unroll
        for (int k = 0; k < 16; ++k) { ex[k] = fexp2((vals[k] - vals[0]) * LOG2E); den += ex[k]; }
        const float inv = 1.0f / den;
        const size_t ob = ((size_t)tok * 8 + h) * 16;
        if (hi == 0) {
#pragma unroll
            for (int w = 0; w < 4; ++w) { v4u o; o.x = ids[4 * w]; o.y = ids[4 * w + 1]; o.z = ids[4 * w + 2]; o.w = ids[4 * w + 3]; *(v4u*)(IDS + ob + 4 * w) = o; }
        } else {
#pragma unroll
            for (int w = 0; w < 4; ++w) { f32x4 o; o.x = ex[4 * w] * inv; o.y = ex[4 * w + 1] * inv; o.z = ex[4 * w + 2] * inv; o.w = ex[4 * w + 3] * inv; *(f32x4*)(GG + ob + 4 * w) = o; }
        }
        LDS_WAIT(); asm volatile("" ::: "memory");
    }
}

__device__ __forceinline__ float dot2u(unsigned a, unsigned b, float acc) { return __builtin_amdgcn_fdot2_f32_bf16(__builtin_bit_cast(bf2_t, a), __builtin_bit_cast(bf2_t, b), acc, false); }
__device__ __forceinline__ float dot8(const v4u a, const v4u b, float acc) {
    acc = dot2u(a.x, b.x, acc); acc = dot2u(a.y, b.y, acc); acc = dot2u(a.z, b.z, acc); acc = dot2u(a.w, b.w, acc);
    return acc;
}
__device__ __forceinline__ void expert_phase(Frame& F, const Args& A) {
    const bf16* X1B = (const bf16*)(F.ws + WS_X1B); const bf16* UB = (const bf16*)(F.ws + WS_UB); const bf16* VB = (const bf16*)(F.ws + WS_VB);
    const int* IDS = (const int*)(F.ws + WS_IDS); const float* GG = (const float*)(F.ws + WS_G);
    const float* gam = A.in[17]; const float* bet = A.in[18];
    const int gw = F.vcu * NWAVES + F.wave, NGW = F.G * NWAVES, lane = F.lane;
    for (int tok = gw; tok < M; tok += NGW) {
        const v4u xa = *(const v4u*)(X1B + (size_t)tok * D + 8 * lane), xb = *(const v4u*)(X1B + (size_t)tok * D + 512 + 8 * lane);
        int idv[2]; float gv[2], av[2] = {0.f, 0.f};
        idv[0] = IDS[(size_t)tok * 128 + lane]; idv[1] = IDS[(size_t)tok * 128 + 64 + lane];
        gv[0] = GG[(size_t)tok * 128 + lane]; gv[1] = GG[(size_t)tok * 128 + 64 + lane];
#pragma unroll
        for (int hf = 0; hf < 2; ++hf)
            for (int jb = 0; jb < 8; ++jb) {
                v4u ra[8], rb[8];
#pragma unroll
                for (int k = 0; k < 8; ++k) { const int id = __builtin_amdgcn_readlane(idv[hf], jb * 8 + k); const bf16* rp = UB + (size_t)id * D + 8 * lane; ra[k] = *(const v4u*)rp; rb[k] = *(const v4u*)(rp + 512); }
#pragma unroll
                for (int k = 0; k < 8; ++k) { float d = dot8(ra[k], xa, 0.f); d = dot8(rb[k], xb, d); d = wave_sum(d); av[hf] = (lane == jb * 8 + k) ? d : av[hf]; }
            }
        float hid[2];
#pragma unroll
        for (int hf = 0; hf < 2; ++hf) hid[hf] = gelu_tanh(av[hf]) * gv[hf];
        float y[16];
#pragma unroll
        for (int e = 0; e < 16; ++e) y[e] = 0.f;
#pragma unroll
        for (int hf = 0; hf < 2; ++hf)
            for (int jb = 0; jb < 8; ++jb) {
                v4u ra[8], rb[8];
#pragma unroll
                for (int k = 0; k < 8; ++k) { const int id = __builtin_amdgcn_readlane(idv[hf], jb * 8 + k); const bf16* rp = VB + (size_t)id * D + 8 * lane; ra[k] = *(const v4u*)rp; rb[k] = *(const v4u*)(rp + 512); }
#pragma unroll
                for (int k = 0; k < 8; ++k) { const float hh = __builtin_bit_cast(float, __builtin_amdgcn_readlane(__builtin_bit_cast(int, hid[hf]), jb * 8 + k));
                    y[0] += hh * bf_lo(ra[k].x); y[1] += hh * bf_hi(ra[k].x); y[2] += hh * bf_lo(ra[k].y); y[3] += hh * bf_hi(ra[k].y);
                    y[4] += hh * bf_lo(ra[k].z); y[5] += hh * bf_hi(ra[k].z); y[6] += hh * bf_lo(ra[k].w); y[7] += hh * bf_hi(ra[k].w);
                    y[8] += hh * bf_lo(rb[k].x); y[9] += hh * bf_hi(rb[k].x); y[10] += hh * bf_lo(rb[k].y); y[11] += hh * bf_hi(rb[k].y);
                    y[12] += hh * bf_lo(rb[k].z); y[13] += hh * bf_hi(rb[k].z); y[14] += hh * bf_lo(rb[k].w); y[15] += hh * bf_hi(rb[k].w); }
            }
        float* xr = F.out + (size_t)tok * D;
        f32x4 x4[4]; x4[0] = *(const f32x4*)(xr + 8 * lane); x4[1] = *(const f32x4*)(xr + 8 * lane + 4); x4[2] = *(const f32x4*)(xr + 512 + 8 * lane); x4[3] = *(const f32x4*)(xr + 512 + 8 * lane + 4);
        float s = 0.f;
#pragma unroll
        for (int e = 0; e < 16; ++e) { y[e] += DN_ALPHA * x4[e >> 2][e & 3]; s += y[e]; }
        const float mean = wave_sum(s) * (1.f / D); float s2 = 0.f;
#pragma unroll
        for (int e = 0; e < 16; ++e) { y[e] -= mean; s2 += y[e] * y[e]; }
        const float rstd = 1.f / sqrtf(wave_sum(s2) * (1.f / D) + LN_EPS);
#pragma unroll
        for (int c = 0; c < 4; ++c) { const int col = (c >> 1) * 512 + 8 * lane + (c & 1) * 4;
            const f32x4 gg = *(const f32x4*)(gam + col), bb = *(const f32x4*)(bet + col);
            f32x4 o; o.x = y[4 * c] * rstd * gg.x + bb.x; o.y = y[4 * c + 1] * rstd * gg.y + bb.y; o.z = y[4 * c + 2] * rstd * gg.z + bb.z; o.w = y[4 * c + 3] * rstd * gg.w + bb.w;
            *(f32x4*)(xr + col) = o; }
    }
}
__device__ __forceinline__ void wave_argmax(float& v, int& i) {
#pragma unroll
    for (int o = 1; o < 64; o <<= 1) { const float ov = __shfl_xor(v, o); const int oi = __shfl_xor(i, o); if (ov > v || (ov == v && oi < i)) { v = ov; i = oi; } }
}
__device__ __forceinline__ void naive_select_phase(Frame& F, const Args& A) {
    const bf16* QP = (const bf16*)(F.ws + WS_QP);
    int* IDS = (int*)(F.ws + WS_IDS); float* GG = (float*)(F.ws + WS_G);
    const int gw = F.vcu * NWAVES + F.wave, NGW = F.G * NWAVES, lane = F.lane;
    for (int task = gw; task < M * 8; task += NGW) {
        const int tok = task >> 3, h = task & 7;
        float tv[2]; int ti[2];
        for (int half = 0; half < 2; ++half) {
            const float* sk = A.in[13 + half];
            const bf16* qsrc = QP + (size_t)tok * 2048 + h * 256 + half * 128;
            float s0 = 0.f, s1 = 0.f;
            for (int d = 0; d < 128; ++d) { const float qv = __uint_as_float((unsigned)qsrc[d] << 16); s0 += qv * sk[lane * 128 + d]; s1 += qv * sk[(lane + 64) * 128 + d]; }
            float keepv = 0.f; int keepi = 0;
            for (int r = 0; r < 16; ++r) {
                float bv = s0; int bi = lane; if (s1 > bv) { bv = s1; bi = lane + 64; }
                wave_argmax(bv, bi);
                if (bi == lane) s0 = -INFINITY; if (bi == lane + 64) s1 = -INFINITY;
                if (lane == r) { keepv = bv; keepi = bi; }
            }
            tv[half] = keepv; ti[half] = keepi;
        }
        float c[4];
#pragma unroll
        for (int k = 0; k < 4; ++k) { const int pos = lane + 64 * k; c[k] = __shfl(tv[0], pos >> 4) + __shfl(tv[1], pos & 15); }
        float fv = 0.f; int fp = 0;
        for (int r = 0; r < 16; ++r) {
            float bv = c[0]; int bi = lane;
#pragma unroll
            for (int k = 1; k < 4; ++k) if (c[k] > bv) { bv = c[k]; bi = lane + 64 * k; }
            wave_argmax(bv, bi);
#pragma unroll
            for (int k = 0; k < 4; ++k) if (bi == lane + 64 * k) c[k] = -INFINITY;
            if (lane == r) { fv = bv; fp = bi; }
        }
        const int e1 = __shfl(ti[0], fp >> 4), e2 = __shfl(ti[1], fp & 15);
        const float mx = __shfl(fv, 0);
        float ex = lane < 16 ? expf(fv - mx) : 0.f;
        const float den = wave_sum(ex);
        if (lane < 16) { IDS[((size_t)tok * 8 + h) * 16 + lane] = e1 * 128 + e2; GG[((size_t)tok * 8 + h) * 16 + lane] = ex / den; }
    }
}
__device__ __forceinline__ void naive_expert_phase(Frame& F, const Args& A) {
    const int* IDS = (const int*)(F.ws + WS_IDS); const float* GG = (const float*)(F.ws + WS_G);
    const float* UT = A.in[15]; const float* VT = A.in[16]; const float* gam = A.in[17]; const float* bet = A.in[18];
    const int gw = F.vcu * NWAVES + F.wave, NGW = F.G * NWAVES, lane = F.lane;
    for (int tok = gw; tok < M; tok += NGW) {
        float* xr = F.out + (size_t)tok * D;
        float x[16], y[16];
#pragma unroll
        for (int e = 0; e < 16; ++e) { x[e] = xr[lane + 64 * e]; y[e] = 0.f; }
        for (int j = 0; j < 128; ++j) {
            const int id = IDS[(size_t)tok * 128 + j]; const float g = GG[(size_t)tok * 128 + j];
            const float* ur = UT + (size_t)id * D; const float* vr = VT + (size_t)id * D;
            float d = 0.f;
#pragma unroll
            for (int e = 0; e < 16; ++e) d += x[e] * ur[lane + 64 * e];
            d = wave_sum(d);
            const float z = 0.7978845608028654f * (d + 0.044715f * d * d * d);
            const float hid = 0.5f * d * (1.0f + tanhf(z)) * g;
#pragma unroll
            for (int e = 0; e < 16; ++e) y[e] += hid * vr[lane + 64 * e];
        }
        float s = 0.f;
#pragma unroll
        for (int e = 0; e < 16; ++e) { y[e] += DN_ALPHA * x[e]; s += y[e]; }
        const float mean = wave_sum(s) * (1.f / D); float s2 = 0.f;
#pragma unroll
        for (int e = 0; e < 16; ++e) { y[e] -= mean; s2 += y[e] * y[e]; }
        const float rstd = 1.f / sqrtf(wave_sum(s2) * (1.f / D) + LN_EPS);
#pragma unroll
        for (int e = 0; e < 16; ++e) xr[lane + 64 * e] = y[e] * rstd * gam[lane + 64 * e] + bet[lane + 64 * e];
    }
}
constexpr int N_PHASES = 9;
#ifndef MK_N_LAUNCHES
#define MK_N_LAUNCHES 1
#endif

__global__ void __launch_bounds__(NWAVES * 64, 2) fwd_megakernel(Args args) {
    extern __shared__ __attribute__((aligned(16))) unsigned char lds[];
    Frame F;
    F.lds = (LAS unsigned char*)lds;
    F.tid = threadIdx.x; F.lane = F.tid & 63; F.wave = __builtin_amdgcn_readfirstlane(F.tid >> 6);
    F.G = gridDim.x; { const int bx = blockIdx.x; F.vcu = (F.G % 8 == 0) ? (bx % 8) * (F.G / 8) + bx / 8 : bx; }
    F.out = args.out; F.ws = args.ws;
    const int lo = args.ph_lo, hi = args.ph_hi;
    cg::grid_group grid = cg::this_grid();
#ifndef PHASE_MASK
#define PHASE_MASK 0x1ff
#endif
#define IN(k) (((PHASE_MASK >> (k)) & 1) && lo <= (k) && (k) < hi)
#define SEAM(k) do { if (IN(k) && IN((k) + 1)) grid.sync(); } while (0)
    typedef pg8::bf16_t b16;

    if (IN(0)) { p0_prologue(F, args); } SEAM(0);
    if (IN(1)) {
        pg8::Gemm g{(const b16*)(F.ws + WS_XB), (const b16*)(F.ws + WS_WIN), M, INC, D}; pg8::StaticOrder S; S.init(M, INC, F.G, (int)blockIdx.x);
        pg8::EpiProj E{(b16*)(F.ws + WS_PROJ)};
        pg8::gemm_phase<pg8::EpiProj, pg8::StaticOrder, true, true>(F.lds, g, S, E);
    } SEAM(1);
    if (IN(2)) { na_phase(F, args); __syncthreads(); sgu_phase(F, args); } SEAM(2);
    if (IN(3)) {
        pg8::Gemm g{(const b16*)(F.ws + WS_YCAT), (const b16*)(F.ws + WS_WCAT), M, D, D}; pg8::StaticOrder S; S.init(M, D, F.G, (int)blockIdx.x);
        pg8::EpiMerge E{(const b16*)(F.ws + WS_PROJ) + C_GA, (const b16*)(F.ws + WS_PROJ) + C_GB, (b16*)(F.ws + WS_XB)};
        pg8::gemm_phase<pg8::EpiMerge, pg8::StaticOrder, true, true>(F.lds, g, S, E);
    } SEAM(3);
    if (IN(4)) {
        pg8::Gemm g{(const b16*)(F.ws + WS_XB), (const b16*)(F.ws + WS_WOUT), M, D, D}; pg8::StaticOrder S; S.init(M, D, F.G, (int)blockIdx.x);
        pg8::EpiResF32 E{args.in[0], F.out};
        pg8::gemm_phase<pg8::EpiResF32, pg8::StaticOrder, true, true>(F.lds, g, S, E);
    } SEAM(4);
    if (IN(5)) { ln1_phase(F, args); } SEAM(5);
    if (IN(6)) {
        pg8::Gemm g{(const b16*)(F.ws + WS_X1B), (const b16*)(F.ws + WS_WQ), M, 2048, D}; pg8::StaticOrder S; S.init(M, 2048, F.G, (int)blockIdx.x);
        pg8::EpiPlain E{(b16*)(F.ws + WS_QP), 2048};
        pg8::gemm_phase<pg8::EpiPlain, pg8::StaticOrder, true, true>(F.lds, g, S, E);
    } SEAM(6);
    #ifdef NAIVE_SELECT
    if (IN(7)) { naive_select_phase(F, args); } SEAM(7);
#else
    if (IN(7)) { select_phase(F, args); } SEAM(7);
#endif
    #ifdef NAIVE_EXPERT
    if (IN(8)) { naive_expert_phase(F, args); }
#else
    if (IN(8)) { expert_phase(F, args); }
#endif
#undef IN
#undef SEAM
}

extern "C" void kernel_launch(void* const* d_in, const int* in_sizes, int n_in, void* d_out, int out_size, void* d_ws, size_t ws_size, hipStream_t stream) {
    static int grid = 0;
    if (grid == 0) {
        if (n_in != 19 || in_sizes[0] != M * D || out_size != M * D || ws_size < WS_END) { fprintf(stderr, "kernel_launch: unexpected shapes (n_in %d, in0 %d, out %d, ws %zu); nothing launched\n", n_in, n_in > 0 ? in_sizes[0] : -1, out_size, ws_size); grid = -1; return; }
        int dev = 0, cus = 0, per_cu = 0;
        if (hipGetDevice(&dev) != hipSuccess || hipDeviceGetAttribute(&cus, hipDeviceAttributeMultiprocessorCount, dev) != hipSuccess) { grid = -1; return; }
        if (hipFuncSetAttribute((const void*)fwd_megakernel, hipFuncAttributeMaxDynamicSharedMemorySize, LDS_BYTES) != hipSuccess) { fprintf(stderr, "kernel_launch: hipFuncSetAttribute failed\n"); grid = -1; return; }
        if (hipOccupancyMaxActiveBlocksPerMultiprocessor(&per_cu, (const void*)fwd_megakernel, NWAVES * 64, LDS_BYTES) != hipSuccess || per_cu < 1) { fprintf(stderr, "kernel_launch: occupancy query says %d blocks per CU\n", per_cu); grid = -1; return; }
        (void)hipGetLastError();
        grid = cus;
    }
    if (grid < 0) return;
    Args a{};
    for (int i = 0; i < 19; ++i) a.in[i] = (const float*)d_in[i];
    a.out = (float*)d_out; a.ws = (unsigned char*)d_ws;
    if (MK_N_LAUNCHES == 1) {
        a.ph_lo = 0; a.ph_hi = N_PHASES;
        void* kargs[] = {&a};
        const hipError_t e = hipLaunchCooperativeKernel((const void*)fwd_megakernel, dim3(grid), dim3(NWAVES * 64), kargs, LDS_BYTES, stream);
        if (e != hipSuccess) fprintf(stderr, "kernel_launch: cooperative launch failed: %s (grid %d)\n", hipGetErrorString(e), grid);
    } else {
        for (int p = 0; p < N_PHASES; ++p) { a.ph_lo = p; a.ph_hi = p + 1;
            hipLaunchKernelGGL(fwd_megakernel, dim3(grid), dim3(NWAVES * 64), LDS_BYTES, stream, a);
            const hipError_t le = hipPeekAtLastError(); if (le != hipSuccess) { fprintf(stderr, "kernel_launch: launch %d failed: %s\n", p, hipGetErrorName(le)); break; } }
    }
}
```

```cpp
#include <hip/hip_runtime.h>
#include <hip/hip_cooperative_groups.h>
#include <cstdio>
#include <cstdint>
namespace cg = cooperative_groups;
#define MK_N_LAUNCHES 1
namespace pg8 {
#define PG8_LAS __attribute__((address_space(3)))
typedef unsigned short bf16_t;
typedef short bf16x8 __attribute__((ext_vector_type(8)));
typedef float f32x4 __attribute__((ext_vector_type(4)));
typedef unsigned u32x4 __attribute__((ext_vector_type(4)));
constexpr int BM = 256, BK = 64, HALF = 128, HTB = HALF * BK * 2  , STAGE_BYTES = 8 * HTB, NXCD = 8, WGM = 8;

__host__ __device__ __forceinline__ int lds_byte(int r, int c) { const int st = (r >> 4) * 2 + (c >> 5), rr = r & 15, cc = c & 31, ob = rr * 64 + cc * 2; return st * 1024 + (ob ^ (((ob >> 9) & 1) << 5)); }
__host__ __device__ __forceinline__ void stage_rc(int b, int& R, int& C) { const int st = b / 1024, sb = b % 1024, swz = sb ^ (((sb >> 9) & 1) << 5); R = (st >> 1) * 16 + swz / 64; C = (st & 1) * 32 + (swz % 64) / 2; }
__host__ __device__ __forceinline__ int perm32(int rho) { const int n = rho >> 4, i = rho & 15; return 8 * (i >> 2) + 4 * n + (i & 3); }

struct Unit { int pm, pn; };
struct Gemm { const bf16_t* A; const bf16_t* Bt; int M, N, K; };

struct StaticOrder {
    int nM, nN, nwg, G, c;
    __host__ __device__ void init(int M, int N, int G_, int c_) { nM = M / BM; nN = N / BM; nwg = nM * nN; G = G_; c = c_; }
    __host__ __device__ bool next(int i, Unit& u) const {
        const long L = (long)i * G + c; if (L >= nwg) return false;
        int wgid = (int)L; { const int q = nwg / NXCD, r = nwg % NXCD, xcd = wgid % NXCD, off = wgid / NXCD; wgid = (xcd < r ? xcd * (q + 1) : r * (q + 1) + (xcd - r) * q) + off; }
        const int nig = WGM * nN, gid = wgid / nig, fm = gid * WGM, gsz = (nM - fm) < WGM ? (nM - fm) : WGM;
        u.pm = fm + ((wgid % nig) % gsz); u.pn = (wgid % nig) / gsz; return true;
    }
    __device__ __forceinline__ void a_ready(const Unit&) const {}
    __device__ __forceinline__ void done(const Unit&) const {}
};

__device__ __forceinline__ unsigned cvt_pk_bf16(float lo, float hi) { unsigned r; asm volatile("v_cvt_pk_bf16_f32 %0, %1, %2" : "=v"(r) : "v"(lo), "v"(hi)); return r; }
template <class Epi, class Sched, bool ALIGN_EPI = false, bool SP2 = false>
__device__ __forceinline__ void gemm_phase(PG8_LAS unsigned char* lds, const Gemm g, const Sched& S, const Epi& E) {
    const int tid = threadIdx.x, wid = __builtin_amdgcn_readfirstlane(tid >> 6), lane = tid & 63, wr = wid >> 2, wc = wid & 3, fr = lane & 15, fq = lane >> 4;
    const int K = g.K, nt = K / BK;
    unsigned voffA[2], voffB[2];
#pragma unroll
    for (int i = 0; i < 2; ++i) { int R, C; stage_rc(tid * 16 + i * 8192, R, C); const int Rb = Epi::PERM ? ((R & ~31) + perm32(R & 31)) : R;
        voffA[i] = (unsigned)(R * K + C) * 2u; voffB[i] = (unsigned)(Rb * K + C) * 2u; }
    const size_t kstep = (size_t)(BK * 2);
    const size_t hstep = (size_t)HALF * K * 2;
    const size_t tstep = 2 * hstep;
    const unsigned ldsw = (unsigned)wid * 1024u;
    const int aoff = lds_byte(wr * 64 + fr, fq * 8), boff = lds_byte(wc * 32 + fr, fq * 8);
#define PG8_SA(b, h) (((b) * 2 + (h)) * HTB)
#define PG8_SB(b, h) ((4 + (b) * 2 + (h)) * HTB)
#define PG8_STAGE(bufoff, gbase, voff) do { _Pragma("unroll") for (int _i = 0; _i < 2; ++_i) \
        __builtin_amdgcn_global_load_lds((const unsigned*)((const char*)(gbase) + (voff)[_i]), (PG8_LAS unsigned*)(lds + (bufoff) + ldsw + _i * 8192), 16, 0, 0); } while (0)
#define PG8_LDA(dst, b, h) do { _Pragma("unroll") for (int m = 0; m < 4; ++m) _Pragma("unroll") for (int k = 0; k < 2; ++k) dst[m][k] = *(const PG8_LAS bf16x8*)(lds + PG8_SA(b, h) + aoff + m * 2048 + k * 1024); } while (0)
#define PG8_LDB(dst, b, h) do { _Pragma("unroll") for (int n = 0; n < 2; ++n) _Pragma("unroll") for (int k = 0; k < 2; ++k) dst[n][k] = *(const PG8_LAS bf16x8*)(lds + PG8_SB(b, h) + boff + n * 2048 + k * 1024); } while (0)
#define PG8_MMA(ai, bj, At, Bt) do { __builtin_amdgcn_s_setprio(1); _Pragma("unroll") for (int m = 0; m < 4; ++m) _Pragma("unroll") for (int n = 0; n < 2; ++n) _Pragma("unroll") for (int k = 0; k < 2; ++k) \
        acc[ai][bj][m][n] = __builtin_amdgcn_mfma_f32_16x16x32_bf16(Bt[n][k], At[m][k], acc[ai][bj][m][n], 0, 0, 0); __builtin_amdgcn_s_setprio(0); } while (0)
#define PG8_WAIT_V(n) asm volatile("s_waitcnt vmcnt(" #n ")" ::: "memory")
#define PG8_WAIT_L(n) asm volatile("s_waitcnt lgkmcnt(" #n ")" ::: "memory")
#define PG8_BAR __builtin_amdgcn_s_barrier()
#define PG8_SCHED __builtin_amdgcn_sched_barrier(0)
    Unit cur, nxt; int ui = 0;
    if (!S.next(0, cur)) return;
    f32x4 acc[2][2][4][2];
#pragma unroll
    for (int a = 0; a < 2; ++a)
#pragma unroll
        for (int b = 0; b < 2; ++b)
#pragma unroll
            for (int m = 0; m < 4; ++m)
#pragma unroll
                for (int n = 0; n < 2; ++n) acc[a][b][m][n] = (f32x4){0.f, 0.f, 0.f, 0.f};
    bf16x8 At[4][2], B0[2][2], B1[2][2];
    const char* cA = (const char*)g.A + (size_t)cur.pm * tstep; const char* cB = (const char*)g.Bt + (size_t)cur.pn * tstep;
    S.a_ready(cur);
    if constexpr (SP2) {
        PG8_STAGE(PG8_SB(0, 0), cB, voffB); PG8_STAGE(PG8_SB(0, 1), cB + hstep, voffB); PG8_STAGE(PG8_SA(0, 0), cA, voffA); PG8_STAGE(PG8_SA(0, 1), cA + hstep, voffA);
        if (wr == 1) PG8_BAR;
        PG8_WAIT_V(2); PG8_BAR;
        PG8_STAGE(PG8_SB(1, 0), cB + kstep, voffB); PG8_STAGE(PG8_SA(1, 0), cA + kstep, voffA); PG8_STAGE(PG8_SB(1, 1), cB + hstep + kstep, voffB);
        PG8_WAIT_V(6); PG8_BAR;
    } else {
        PG8_STAGE(PG8_SB(0, 0), cB, voffB); PG8_STAGE(PG8_SA(0, 0), cA, voffA); PG8_STAGE(PG8_SB(0, 1), cB + hstep, voffB); PG8_STAGE(PG8_SA(0, 1), cA + hstep, voffA);
        if (wr == 1) PG8_BAR;
        PG8_WAIT_V(4); PG8_BAR;
        PG8_STAGE(PG8_SB(1, 0), cB + kstep, voffB); PG8_STAGE(PG8_SA(1, 0), cA + kstep, voffA); PG8_STAGE(PG8_SB(1, 1), cB + hstep + kstep, voffB);
        PG8_WAIT_V(6); PG8_BAR;
    }
    for (;;) {
        const bool has_next = S.next(ui + 1, nxt);
        const char* nA = has_next ? (const char*)g.A + (size_t)nxt.pm * tstep : cA; const char* nB = has_next ? (const char*)g.Bt + (size_t)nxt.pn * tstep : cB;
        for (int t = 0; t < nt; t += 2) {
            const bool last = (t == nt - 2);
            if constexpr (Epi::HAS_MID) { if (t == (nt >> 1)) E.mid(acc, cur, wr, wc, fr, fq); }
            const char* a1 = cA + (size_t)(t + 1) * kstep;
            const char* a2 = last ? nA : cA + (size_t)(t + 2) * kstep; const char* b2 = last ? nB : cB + (size_t)(t + 2) * kstep;
            const char* a3 = a2 + kstep; const char* b3 = b2 + kstep;
            if (last && has_next) S.a_ready(nxt);
            if constexpr (SP2) {
            PG8_LDB(B0, 0, 0); PG8_LDB(B1, 0, 1); PG8_SCHED; PG8_LDA(At, 0, 0); PG8_STAGE(PG8_SA(1, 1), a1 + hstep, voffA);
            PG8_WAIT_V(8); PG8_WAIT_L(0); PG8_BAR; PG8_MMA(0, 0, At, B0); PG8_MMA(0, 1, At, B1); PG8_BAR; PG8_SCHED;
            PG8_LDA(At, 0, 1); PG8_STAGE(PG8_SB(0, 0), b2, voffB); PG8_STAGE(PG8_SB(0, 1), b2 + hstep, voffB); PG8_STAGE(PG8_SA(0, 0), a2, voffA);
            PG8_WAIT_V(8); PG8_WAIT_L(0); PG8_BAR; PG8_MMA(1, 0, At, B0); PG8_MMA(1, 1, At, B1); PG8_BAR; PG8_SCHED;
            PG8_LDB(B0, 1, 0); PG8_LDB(B1, 1, 1); PG8_SCHED; PG8_LDA(At, 1, 0); PG8_STAGE(PG8_SA(0, 1), a2 + hstep, voffA);
            PG8_WAIT_V(8); PG8_WAIT_L(0); PG8_BAR; PG8_MMA(0, 0, At, B0); PG8_MMA(0, 1, At, B1); PG8_BAR; PG8_SCHED;
            PG8_LDA(At, 1, 1); PG8_STAGE(PG8_SB(1, 0), b3, voffB); PG8_STAGE(PG8_SB(1, 1), b3 + hstep, voffB); PG8_STAGE(PG8_SA(1, 0), a3, voffA);
            PG8_WAIT_V(8); PG8_WAIT_L(0); PG8_BAR; PG8_MMA(1, 0, At, B0); PG8_MMA(1, 1, At, B1); PG8_BAR; PG8_SCHED;
            } else {
            PG8_LDB(B0, 0, 0); PG8_SCHED; PG8_LDA(At, 0, 0); PG8_STAGE(PG8_SA(1, 1), a1 + hstep, voffA);
            PG8_WAIT_L(8); PG8_BAR; PG8_WAIT_L(0); PG8_MMA(0, 0, At, B0); PG8_BAR; PG8_SCHED;
            PG8_LDB(B1, 0, 1); PG8_STAGE(PG8_SB(0, 0), b2, voffB);
            PG8_BAR; PG8_WAIT_L(0); PG8_MMA(0, 1, At, B1); PG8_BAR;
            PG8_LDA(At, 0, 1); PG8_STAGE(PG8_SA(0, 0), a2, voffA);
            PG8_BAR; PG8_WAIT_L(0); PG8_MMA(1, 0, At, B0); PG8_BAR; PG8_SCHED;
            PG8_STAGE(PG8_SB(0, 1), b2 + hstep, voffB);
            PG8_WAIT_V(6); PG8_BAR; PG8_MMA(1, 1, At, B1); PG8_BAR;
            PG8_LDB(B0, 1, 0); PG8_SCHED; PG8_LDA(At, 1, 0); PG8_STAGE(PG8_SA(0, 1), a2 + hstep, voffA);
            PG8_WAIT_L(8); PG8_BAR; PG8_WAIT_L(0); PG8_MMA(0, 0, At, B0); PG8_BAR; PG8_SCHED;
            PG8_LDB(B1, 1, 1); PG8_STAGE(PG8_SB(1, 0), b3, voffB);
            PG8_BAR; PG8_WAIT_L(0); PG8_MMA(0, 1, At, B1); PG8_BAR;
            PG8_LDA(At, 1, 1); PG8_STAGE(PG8_SA(1, 0), a3, voffA);
            PG8_BAR; PG8_WAIT_L(0); PG8_MMA(1, 0, At, B0); PG8_BAR; PG8_SCHED;
            PG8_STAGE(PG8_SB(1, 1), b3 + hstep, voffB);
            PG8_WAIT_V(6); PG8_BAR; PG8_MMA(1, 1, At, B1); PG8_BAR;
            }
        }
        if constexpr (ALIGN_EPI) { if (wr == 0) PG8_BAR; }
        if constexpr (!Epi::AFTER_DRAIN) { E(acc, cur, wr, wc, fr, fq); S.done(cur); }
        if (!has_next) break;
#pragma unroll
        for (int a = 0; a < 2; ++a)
#pragma unroll
            for (int b = 0; b < 2; ++b)
#pragma unroll
                for (int m = 0; m < 4; ++m)
#pragma unroll
                    for (int n = 0; n < 2; ++n) acc[a][b][m][n] = (f32x4){0.f, 0.f, 0.f, 0.f};
        cur = nxt; cA = nA; cB = nB; ++ui;
        if constexpr (ALIGN_EPI) { if (wr == 1) PG8_BAR; }
    }
    PG8_WAIT_V(0);
    if constexpr (!ALIGN_EPI) { if (wr == 0) PG8_BAR; }
    PG8_BAR;
    if constexpr (Epi::AFTER_DRAIN) { E.fused(acc, cur, wr, wc, fr, fq, lds, wid, lane); S.done(cur); }
#undef PG8_SA
#undef PG8_SB
#undef PG8_STAGE
#undef PG8_LDA
#undef PG8_LDB
#undef PG8_MMA
#undef PG8_WAIT_V
#undef PG8_WAIT_L
#undef PG8_BAR
#undef PG8_SCHED
}
}
constexpr int NWAVES = 8;
constexpr int M = 16384, D = 1024, INC = 4608;
constexpr int GRID_W = 64, NROWS = 256;
constexpr int C_Q = 0, C_K = 512, C_V = 1024, C_SU = 1536, C_SV = 2048, C_GA = 2560, C_GB = 3584;
constexpr int NEXP = 16384;
constexpr float LN_EPS = 1e-5f;
constexpr float DN_ALPHA = 1.189207115002721f;
constexpr float LOG2E = 1.4426950408889634f;
constexpr float QSCALE = 0.125f * LOG2E;

constexpr size_t MiB = 1u << 20;
constexpr size_t WS_CTL = 0, CTL_ZERO_BYTES = 64 * 1024;
constexpr size_t WS_WIN = 1 * MiB;
constexpr size_t WS_WCAT = 10 * MiB;
constexpr size_t WS_WOUT = 12 * MiB;
constexpr size_t WS_WQ = 14 * MiB;
constexpr size_t WS_SK = 18 * MiB;
constexpr size_t WS_WS = 18 * MiB + 65536;
constexpr size_t WS_XB = 20 * MiB;
constexpr size_t WS_PROJ = 52 * MiB;
constexpr size_t WS_YCAT = 196 * MiB;
constexpr size_t WS_X1B = 52 * MiB;
constexpr size_t WS_UB = 84 * MiB;
constexpr size_t WS_VB = 116 * MiB;
constexpr size_t WS_QP = 148 * MiB;
constexpr size_t WS_IDS = 212 * MiB;
constexpr size_t WS_G = 220 * MiB;
constexpr size_t WS_END = 256 * MiB;

constexpr int RING_BYTES = 131072;
constexpr int LDS_BYTES = 147456;

#define GAS __attribute__((address_space(1)))
#define LAS __attribute__((address_space(3)))
typedef unsigned short bf16;
typedef unsigned v4u __attribute__((ext_vector_type(4)));
typedef unsigned v2u __attribute__((ext_vector_type(2)));
typedef float f32x4 __attribute__((ext_vector_type(4)));
typedef float f32x16 __attribute__((ext_vector_type(16)));
typedef short bf16x8 __attribute__((ext_vector_type(8)));
typedef __bf16 bf2_t __attribute__((ext_vector_type(2)));
typedef float f32x2_t __attribute__((ext_vector_type(2)));

__device__ __forceinline__ unsigned pk2(float lo, float hi) { f32x2_t v = {lo, hi}; bf2_t b = __builtin_convertvector(v, bf2_t); return __builtin_bit_cast(unsigned, b); }
__device__ __forceinline__ float bf_lo(unsigned u) { return __uint_as_float(u << 16); }
__device__ __forceinline__ float bf_hi(unsigned u) { return __uint_as_float(u & 0xffff0000u); }
__device__ __forceinline__ float fexp2(float x) { return __builtin_amdgcn_exp2f(x); }
__device__ __forceinline__ float frcp(float x) { return __builtin_amdgcn_rcpf(x); }
__device__ __forceinline__ float sigmoidf_(float x) { return frcp(1.0f + fexp2(-LOG2E * x)); }
__device__ __forceinline__ float gelu_tanh(float x) { const float z = 1.5957691216057308f * (x + 0.044715f * x * x * x); return x * frcp(1.0f + fexp2(-LOG2E * z)); }
__device__ __forceinline__ float wave_sum(float v) {
#pragma unroll
    for (int o = 1; o < 64; o <<= 1) v += __shfl_xor(v, o);
    return v;
}
__device__ __forceinline__ int crow(int r, int hi) { return (r & 3) + 8 * (r >> 2) + 4 * hi; }
#define MFMA32(a, b, c) __builtin_amdgcn_mfma_f32_32x32x16_bf16((a), (b), (c), 0, 0, 0)
#define LDS_WAIT() asm volatile("s_waitcnt lgkmcnt(0)" ::: "memory")

namespace pg8 {
struct EpiProj {
    static constexpr bool PERM = true, AFTER_DRAIN = false, HAS_MID = false;
    bf16_t* O;
    __device__ __forceinline__ void operator()(const f32x4 (&acc)[2][2][4][2], const Unit& u, int wr, int wc, int fr, int fq) const {
        const int row0 = u.pm * BM + wr * 64 + fr, col0 = u.pn * BM + wc * 32 + 8 * fq;
        const int type = u.pn < 2 ? 0 : (u.pn < 6 ? 1 : (u.pn < 10 ? 2 : 3));
#pragma unroll
        for (int ai = 0; ai < 2; ++ai)
#pragma unroll
            for (int m = 0; m < 4; ++m) { bf16_t* rowp = O + (size_t)(row0 + ai * HALF + m * 16) * INC + col0;
#pragma unroll
                for (int bj = 0; bj < 2; ++bj) { f32x4 v0 = acc[ai][bj][m][0], v1 = acc[ai][bj][m][1];
                    if (type == 0) { v0 = v0 * QSCALE; v1 = v1 * QSCALE; }
                    else if (type == 2) {
#pragma unroll
                        for (int e = 0; e < 4; ++e) { v0[e] = gelu_tanh(v0[e]); v1[e] = gelu_tanh(v1[e]); } }
                    else if (type == 3) {
#pragma unroll
                        for (int e = 0; e < 4; ++e) { v0[e] = sigmoidf_(v0[e]); v1[e] = sigmoidf_(v1[e]); } }
                    u32x4 w; w.x = pk2(v0[0], v0[1]); w.y = pk2(v0[2], v0[3]); w.z = pk2(v1[0], v1[1]); w.w = pk2(v1[2], v1[3]);
                    *(u32x4*)(rowp + bj * HALF) = w; } }
    }
};
struct EpiPlain {
    static constexpr bool PERM = true, AFTER_DRAIN = false, HAS_MID = false;
    bf16_t* O; int ldc;
    __device__ __forceinline__ void operator()(const f32x4 (&acc)[2][2][4][2], const Unit& u, int wr, int wc, int fr, int fq) const {
        const int row0 = u.pm * BM + wr * 64 + fr, col0 = u.pn * BM + wc * 32 + 8 * fq;
#pragma unroll
        for (int ai = 0; ai < 2; ++ai)
#pragma unroll
            for (int m = 0; m < 4; ++m) { bf16_t* rowp = O + (size_t)(row0 + ai * HALF + m * 16) * ldc + col0;
#pragma unroll
                for (int bj = 0; bj < 2; ++bj) { const f32x4 v0 = acc[ai][bj][m][0], v1 = acc[ai][bj][m][1];
                    u32x4 w; w.x = pk2(v0[0], v0[1]); w.y = pk2(v0[2], v0[3]); w.z = pk2(v1[0], v1[1]); w.w = pk2(v1[2], v1[3]);
                    *(u32x4*)(rowp + bj * HALF) = w; } }
    }
};
struct EpiMerge {
    static constexpr bool PERM = true, AFTER_DRAIN = false, HAS_MID = true;
    const bf16_t* SA; const bf16_t* SB; bf16_t* O;
    __device__ __forceinline__ void mid(f32x4 (&acc)[2][2][4][2], const Unit& u, int wr, int wc, int fr, int fq) const {
        int row0 = u.pm * BM + wr * 64 + fr; const int col0 = u.pn * BM + wc * 32 + 8 * fq;
        asm volatile("" : "+v"(row0));
#pragma unroll
        for (int ai = 0; ai < 2; ++ai)
#pragma unroll
            for (int m = 0; m < 4; ++m) { const unsigned off = (unsigned)((row0 + ai * HALF + m * 16) * INC + col0) * 2u;
#pragma unroll
                for (int bj = 0; bj < 2; ++bj) { const u32x4 a = *(const u32x4*)((const char*)SA + off + bj * HALF * 2), b = *(const u32x4*)((const char*)SB + off + bj * HALF * 2);
                    f32x4 r0, r1;
                    r0[0] = bf_lo(a.x) * frcp(bf_lo(b.x)); r0[1] = bf_hi(a.x) * frcp(bf_hi(b.x)); r0[2] = bf_lo(a.y) * frcp(bf_lo(b.y)); r0[3] = bf_hi(a.y) * frcp(bf_hi(b.y));
                    r1[0] = bf_lo(a.z) * frcp(bf_lo(b.z)); r1[1] = bf_hi(a.z) * frcp(bf_hi(b.z)); r1[2] = bf_lo(a.w) * frcp(bf_lo(b.w)); r1[3] = bf_hi(a.w) * frcp(bf_hi(b.w));
                    acc[ai][bj][m][0] = acc[ai][bj][m][0] * r0; acc[ai][bj][m][1] = acc[ai][bj][m][1] * r1; }
                if (m & 1) asm volatile("" ::: "memory"); }
    }
    __device__ __forceinline__ void operator()(const f32x4 (&acc)[2][2][4][2], const Unit& u, int wr, int wc, int fr, int fq) const {
        const int row0 = u.pm * BM + wr * 64 + fr, col0 = u.pn * BM + wc * 32 + 8 * fq;
#pragma unroll
        for (int ai = 0; ai < 2; ++ai)
#pragma unroll
            for (int m = 0; m < 4; ++m) { const int row = row0 + ai * HALF + m * 16;
#pragma unroll
                for (int bj = 0; bj < 2; ++bj) { const u32x4 b = *(const u32x4*)(SB + (size_t)row * INC + col0 + bj * HALF);
                    const f32x4 v0 = acc[ai][bj][m][0], v1 = acc[ai][bj][m][1];
                    u32x4 w; w.x = pk2(v0[0] * bf_lo(b.x), v0[1] * bf_hi(b.x)); w.y = pk2(v0[2] * bf_lo(b.y), v0[3] * bf_hi(b.y));
                    w.z = pk2(v1[0] * bf_lo(b.z), v1[1] * bf_hi(b.z)); w.w = pk2(v1[2] * bf_lo(b.w), v1[3] * bf_hi(b.w));
                    *(u32x4*)(O + (size_t)row * D + col0 + bj * HALF) = w; } }
    }
};
struct EpiResF32 {
    static constexpr bool PERM = false, AFTER_DRAIN = false, HAS_MID = false;
    const float* X; float* O;
    __device__ __forceinline__ void operator()(const f32x4 (&acc)[2][2][4][2], const Unit& u, int wr, int wc, int fr, int fq) const {
        const int row0 = u.pm * BM + wr * 64 + fr, col0 = u.pn * BM + wc * 32 + 4 * fq;
#pragma unroll
        for (int ai = 0; ai < 2; ++ai)
#pragma unroll
            for (int m = 0; m < 4; ++m) { const size_t off = (size_t)(row0 + ai * HALF + m * 16) * D + col0;
#pragma unroll
                for (int bj = 0; bj < 2; ++bj)
#pragma unroll
                    for (int n = 0; n < 2; ++n) { const f32x4 xv = *(const f32x4*)(X + off + bj * HALF + n * 16);
                        *(f32x4*)(O + off + bj * HALF + n * 16) = acc[ai][bj][m][n] + xv * DN_ALPHA; } }
    }
};
}

struct Frame {
    LAS unsigned char* lds;
    int tid, lane, wave, vcu, G;
    float* out;
    unsigned char* ws;
};
struct Args { const float* in[19]; float* out; unsigned char* ws; int ph_lo, ph_hi, alt, pad; };

__device__ __forceinline__ void p0_transpose_item(const float* W, int N, bf16* WT, int ldo, int koff, LAS float* scr, int item, int lane) {
    const int nblk = N / 32, kb = item / nblk, nb = item % nblk, k0 = 64 * kb, n0 = 32 * nb;
#pragma unroll 8
    for (int i = 0; i < 32; ++i) { const int kk = 2 * i + (lane >> 5); scr[kk * 33 + (lane & 31)] = W[(size_t)(k0 + kk) * N + n0 + (lane & 31)]; }
    LDS_WAIT(); asm volatile("" ::: "memory");
    const int c = lane & 7;
#pragma unroll
    for (int j = 0; j < 4; ++j) { const int n = (lane >> 3) + 8 * j; const LAS float* s = scr + (8 * c) * 33 + n;
        v4u o; o.x = pk2(s[0 * 33], s[1 * 33]); o.y = pk2(s[2 * 33], s[3 * 33]); o.z = pk2(s[4 * 33], s[5 * 33]); o.w = pk2(s[6 * 33], s[7 * 33]);
        *(v4u*)(WT + (size_t)(n0 + n) * ldo + koff + k0 + 8 * c) = o; }
    LDS_WAIT(); asm volatile("" ::: "memory");
}
__device__ __forceinline__ void cvt_stream(const float* src, bf16* dst, size_t n8, int gw, int NGW, int lane) {
    for (size_t i = (size_t)gw * 64 + lane; i < n8; i += (size_t)NGW * 64) {
        const f32x4 a = ((const f32x4*)src)[2 * i], b = ((const f32x4*)src)[2 * i + 1];
        v4u o; o.x = pk2(a[0], a[1]); o.y = pk2(a[2], a[3]); o.z = pk2(b[0], b[1]); o.w = pk2(b[2], b[3]);
        ((v4u*)dst)[i] = o; }
}
__device__ __forceinline__ void p0_prologue(Frame& F, const Args& A) {
    LAS float* scr = (LAS float*)(F.lds + F.wave * 16384);
    const int gw = F.vcu * NWAVES + F.wave, NGW = F.G * NWAVES;
    constexpr int I_WIN = (1024 / 64) * (INC / 32), I_BR = (512 / 64) * (1024 / 32), I_OUT = (1024 / 64) * (1024 / 32), I_WQ = (1024 / 64) * (2048 / 32);
    constexpr int NITEMS = I_WIN + 2 * I_BR + I_OUT + I_WQ;
    bf16* WinT = (bf16*)(F.ws + WS_WIN); bf16* WcatT = (bf16*)(F.ws + WS_WCAT); bf16* WoutT = (bf16*)(F.ws + WS_WOUT); bf16* WqT = (bf16*)(F.ws + WS_WQ);
    for (int it = gw; it < NITEMS; it += NGW) {
        int r = it;
        if (r < I_WIN) { p0_transpose_item(A.in[1], INC, WinT, 1024, 0, scr, r, F.lane); continue; } r -= I_WIN;
        if (r < I_BR) { p0_transpose_item(A.in[7], 1024, WcatT, 1024, 0, scr, r, F.lane); continue; } r -= I_BR;
        if (r < I_BR) { p0_transpose_item(A.in[8], 1024, WcatT, 1024, 512, scr, r, F.lane); continue; } r -= I_BR;
        if (r < I_OUT) { p0_transpose_item(A.in[9], 1024, WoutT, 1024, 0, scr, r, F.lane); continue; } r -= I_OUT;
        p0_transpose_item(A.in[12], 2048, WqT, 1024, 0, scr, r, F.lane);
    }
    cvt_stream(A.in[0], (bf16*)(F.ws + WS_XB), (size_t)M * D / 8, gw, NGW, F.lane);
    cvt_stream(A.in[13], (bf16*)(F.ws + WS_SK), 128 * 128 / 8, gw, NGW, F.lane);
    cvt_stream(A.in[14], (bf16*)(F.ws + WS_SK) + 128 * 128, 128 * 128 / 8, gw, NGW, F.lane);
    cvt_stream(A.in[5], (bf16*)(F.ws + WS_WS), 4 * 128 * 128 / 8, gw, NGW, F.lane);
}

__device__ __forceinline__ void na_phase(Frame& F, const Args& A) {
    const bf16* PROJ = (const bf16*)(F.ws + WS_PROJ); bf16* YCAT = (bf16*)(F.ws + WS_YCAT);
    const float* rpb = A.in[2];
    const int lane = F.lane, h = F.wave, q = lane & 31, hi = lane >> 5;
    LAS float* tab = (LAS float*)(F.lds + h * 4096);
    const float NEG = -INFINITY;
    for (int r = F.vcu; r < NROWS; r += F.G) {
        for (int i = lane; i < 15 * 31; i += 64) tab[64 + i] = rpb[h * 465 + i] * LOG2E;
        LDS_WAIT(); asm volatile("" ::: "memory");
        const int rs = min(max(r - 4, 0), NROWS - 8);
        bf16x8 Qf[2][4];
#pragma unroll
        for (int qt = 0; qt < 2; ++qt)
#pragma unroll
            for (int s = 0; s < 4; ++s) Qf[qt][s] = *(const bf16x8*)(PROJ + (size_t)(r * 64 + 32 * qt + q) * INC + C_Q + h * 64 + 16 * s + 8 * hi);
        f32x16 O[2][2];
#pragma unroll
        for (int a = 0; a < 2; ++a)
#pragma unroll
            for (int b = 0; b < 2; ++b)
#pragma unroll
                for (int e = 0; e < 16; ++e) O[a][b][e] = 0.f;
        float mrun[2] = {NEG, NEG}, lsum[2] = {0.f, 0.f};
        int lane_c[2], lane_off[2];
#pragma unroll
        for (int qt = 0; qt < 2; ++qt) { const int qc = 32 * qt + q, cs = min(max(qc - 8, 0), GRID_W - 16); lane_c[qt] = 4 * hi - cs; lane_off[qt] = 4 * hi - qc + 15 + 64; }
        for (int kr = 0; kr < 8; ++kr) {
            const int krow = rs + kr, dr = krow - r + 7;
            const LAS float* tb = tab + dr * 31;
            const bf16* Kb = PROJ + (size_t)(krow * 64) * INC + C_K + h * 64;
            const bf16* Vb = PROJ + (size_t)(krow * 64) * INC + C_V + h * 64;
            f32x16 S[2][2];
#pragma unroll
            for (int kc = 0; kc < 2; ++kc) {
                bf16x8 Kf[4];
#pragma unroll
                for (int s = 0; s < 4; ++s) Kf[s] = *(const bf16x8*)(Kb + (size_t)(32 * kc + q) * INC + 16 * s + 8 * hi);
#pragma unroll
                for (int qt = 0; qt < 2; ++qt) { f32x16 a;
#pragma unroll
                    for (int e = 0; e < 16; ++e) a[e] = 0.f;
#pragma unroll
                    for (int s = 0; s < 4; ++s) a = MFMA32(Kf[s], Qf[qt][s], a);
                    S[qt][kc] = a; }
            }
#pragma unroll
            for (int qt = 0; qt < 2; ++qt) {
                float mx = NEG;
#pragma unroll
                for (int kc = 0; kc < 2; ++kc)
#pragma unroll
                    for (int e = 0; e < 16; ++e) { const int kcc = 32 * kc + crow(e, 0);
                        const bool valid = (unsigned)(kcc + lane_c[qt]) < 16u;
                        const float bsv = tb[kcc + lane_off[qt]];
                        const float v = valid ? S[qt][kc][e] + bsv : NEG;
                        S[qt][kc][e] = v; mx = fmaxf(mx, v); }
                mx = fmaxf(mx, __shfl_xor(mx, 32));
                const float mnew = fmaxf(mrun[qt], mx), alpha = fexp2(mrun[qt] - mnew); mrun[qt] = mnew;
                float ps = 0.f;
#pragma unroll
                for (int kc = 0; kc < 2; ++kc)
#pragma unroll
                    for (int e = 0; e < 16; ++e) { const float p = fexp2(S[qt][kc][e] - mnew); S[qt][kc][e] = p; ps += p; }
                lsum[qt] = lsum[qt] * alpha + ps;
#pragma unroll
                for (int dt = 0; dt < 2; ++dt)
#pragma unroll
                    for (int e = 0; e < 16; ++e) O[dt][qt][e] *= alpha;
            }
#pragma unroll
            for (int kc = 0; kc < 2; ++kc)
#pragma unroll
                for (int s2 = 0; s2 < 2; ++s2) {
                    bf16x8 Pf[2];
#pragma unroll
                    for (int qt = 0; qt < 2; ++qt) { v4u w;
                        w.x = pk2(S[qt][kc][8 * s2 + 0], S[qt][kc][8 * s2 + 1]); w.y = pk2(S[qt][kc][8 * s2 + 2], S[qt][kc][8 * s2 + 3]);
                        w.z = pk2(S[qt][kc][8 * s2 + 4], S[qt][kc][8 * s2 + 5]); w.w = pk2(S[qt][kc][8 * s2 + 6], S[qt][kc][8 * s2 + 7]);
                        Pf[qt] = __builtin_bit_cast(bf16x8, w); }
#pragma unroll
                    for (int dt = 0; dt < 2; ++dt) {
                        bf16x8 Vf;
#pragma unroll
                        for (int j = 0; j < 8; ++j) { const int kk = 16 * s2 + 8 * (j >> 2) + (j & 3);
                            Vf[j] = (short)Vb[(size_t)(32 * kc + kk + 4 * hi) * INC + 32 * dt + q]; }
#pragma unroll
                        for (int qt = 0; qt < 2; ++qt) O[dt][qt] = MFMA32(Vf, Pf[qt], O[dt][qt]);
                    }
                }
        }
#pragma unroll
        for (int qt = 0; qt < 2; ++qt) {
            const float lt = lsum[qt] + __shfl_xor(lsum[qt], 32), inv = 1.0f / lt;
            bf16* orow = YCAT + (size_t)(r * 64 + 32 * qt + q) * D + h * 64;
#pragma unroll
            for (int dt = 0; dt < 2; ++dt)
#pragma unroll
                for (int g4 = 0; g4 < 4; ++g4) { v2u w; w.x = pk2(O[dt][qt][4 * g4 + 0] * inv, O[dt][qt][4 * g4 + 1] * inv); w.y = pk2(O[dt][qt][4 * g4 + 2] * inv, O[dt][qt][4 * g4 + 3] * inv);
                    *(v2u*)(orow + 32 * dt + 8 * g4 + 4 * hi) = w; }
        }
    }
}

__device__ __forceinline__ void sgu_phase(Frame& F, const Args& A) {
    const bf16* PROJ = (const bf16*)(F.ws + WS_PROJ); bf16* YCAT = (bf16*)(F.ws + WS_YCAT);
    const bf16* WsB = (const bf16*)(F.ws + WS_WS);
    const float* gam = A.in[3]; const float* bet = A.in[4]; const float* bsp = A.in[6];
    LAS float* stats = (LAS float*)(F.lds);
    constexpr int VTP = 136;
    LAS bf16* VT = (LAS bf16*)(F.lds + 1024);
    const int tid = F.tid, lane = F.lane, q31 = lane & 31, hi = lane >> 5;
    for (int u = F.vcu; u < 512; u += F.G) {
        const int n = u >> 2, g = u & 3, tok0 = n * 128;
        {
            const int qq = tid >> 2, part = tid & 3;
            const v4u* src = (const v4u*)(PROJ + (size_t)(tok0 + qq) * INC + C_SV + part * 128);
            v4u buf[16];
#pragma unroll
            for (int i = 0; i < 16; ++i) buf[i] = src[i];
            float s = 0.f;
#pragma unroll
            for (int i = 0; i < 16; ++i) s += (bf_lo(buf[i].x) + bf_hi(buf[i].x)) + (bf_lo(buf[i].y) + bf_hi(buf[i].y)) + (bf_lo(buf[i].z) + bf_hi(buf[i].z)) + (bf_lo(buf[i].w) + bf_hi(buf[i].w));
            s += __shfl_xor(s, 1); s += __shfl_xor(s, 2);
            const float mean = s * (1.0f / 512.0f);
            float v2 = 0.f;
#pragma unroll
            for (int i = 0; i < 16; ++i) {
                const unsigned w[4] = {buf[i].x, buf[i].y, buf[i].z, buf[i].w};
#pragma unroll
                for (int e = 0; e < 4; ++e) { const float a = bf_lo(w[e]) - mean, b = bf_hi(w[e]) - mean; v2 += a * a + b * b; } }
            v2 += __shfl_xor(v2, 1); v2 += __shfl_xor(v2, 2);
            if (part == 0) { stats[2 * qq] = mean; stats[2 * qq + 1] = 1.0f / sqrtf(v2 * (1.0f / 512.0f) + LN_EPS); }
        }
        __syncthreads();
        {
            const int qq = tid & 127, cb = __builtin_amdgcn_readfirstlane(tid >> 7), c0 = cb * 32;
            const v4u* src = (const v4u*)(PROJ + (size_t)(tok0 + qq) * INC + C_SV + g * 128 + c0);
            const float mean = stats[2 * qq], rstd = stats[2 * qq + 1];
#pragma unroll
            for (int i = 0; i < 4; ++i) { const v4u b = src[i]; const unsigned w[4] = {b.x, b.y, b.z, b.w};
#pragma unroll
                for (int e = 0; e < 4; ++e) { const int c = c0 + 8 * i + 2 * e;
                    const float y0 = (bf_lo(w[e]) - mean) * rstd * gam[g * 128 + c] + bet[g * 128 + c];
                    const float y1 = (bf_hi(w[e]) - mean) * rstd * gam[g * 128 + c + 1] + bet[g * 128 + c + 1];
                    const unsigned pk = pk2(y0, y1);
                    VT[c * VTP + qq] = (bf16)(pk & 0xffffu); VT[(c + 1) * VTP + qq] = (bf16)(pk >> 16); } }
        }
        __syncthreads();
        const int ct = F.wave >> 1, pt0 = (F.wave & 1) * 2;
        f32x16 acc[2];
#pragma unroll
        for (int i = 0; i < 2; ++i)
#pragma unroll
            for (int e = 0; e < 16; ++e) acc[i][e] = 0.f;
#pragma unroll
        for (int s = 0; s < 8; ++s) {
            const bf16x8 a = *(const LAS bf16x8*)(VT + (ct * 32 + q31) * VTP + 16 * s + 8 * hi);
#pragma unroll
            for (int i = 0; i < 2; ++i) { const bf16x8 b = *(const bf16x8*)(WsB + (size_t)(g * 128 + (pt0 + i) * 32 + q31) * 128 + 16 * s + 8 * hi); acc[i] = MFMA32(a, b, acc[i]); }
        }
#pragma unroll
        for (int i = 0; i < 2; ++i) { const int p = (pt0 + i) * 32 + q31, tok = tok0 + p; const float bsv = bsp[g * 128 + p];
#pragma unroll
            for (int g4 = 0; g4 < 4; ++g4) { const int c = ct * 32 + 8 * g4 + 4 * hi;
                const v2u uu = *(const v2u*)(PROJ + (size_t)tok * INC + C_SU + g * 128 + c);
                v2u w; w.x = pk2(bf_lo(uu.x) * (acc[i][4 * g4 + 0] + bsv), bf_hi(uu.x) * (acc[i][4 * g4 + 1] + bsv));
                w.y = pk2(bf_lo(uu.y) * (acc[i][4 * g4 + 2] + bsv), bf_hi(uu.y) * (acc[i][4 * g4 + 3] + bsv));
                *(v2u*)(YCAT + (size_t)tok * D + 512 + g * 128 + c) = w; } }
        __syncthreads();
    }
}

__device__ __forceinline__ void ln1_phase(Frame& F, const Args& A) {
    const int gw = F.vcu * NWAVES + F.wave, NGW = F.G * NWAVES, lane = F.lane;
    const float* gam = A.in[10]; const float* bet = A.in[11];
    bf16* X1B = (bf16*)(F.ws + WS_X1B);
    for (int m = gw; m < M; m += NGW) {
        f32x4* xr = (f32x4*)(F.out + (size_t)m * D) + lane;
        f32x4 v[4]; float s = 0.f;
#pragma unroll
        for (int j = 0; j < 4; ++j) { v[j] = xr[64 * j]; s += (v[j].x + v[j].y) + (v[j].z + v[j].w); }
        const float mean = wave_sum(s) * (1.f / D); float s2 = 0.f;
#pragma unroll
        for (int j = 0; j < 4; ++j) { v[j] = v[j] - mean; s2 += (v[j].x * v[j].x + v[j].y * v[j].y) + (v[j].z * v[j].z + v[j].w * v[j].w); }
        const float rstd = 1.f / sqrtf(wave_sum(s2) * (1.f / D) + LN_EPS);
        v2u* o8 = (v2u*)(X1B + (size_t)m * D) + lane;
#pragma unroll
        for (int j = 0; j < 4; ++j) { const f32x4 gg = ((const f32x4*)gam)[lane + 64 * j], bb = ((const f32x4*)bet)[lane + 64 * j];
            const f32x4 y = v[j] * rstd * gg + bb; xr[64 * j] = y;
            v2u w; w.x = pk2(y.x, y.y); w.y = pk2(y.z, y.w); o8[64 * j] = w; }
    }
    cvt_stream(A.in[15], (bf16*)(F.ws + WS_UB), (size_t)NEXP * D / 8, gw, NGW, lane);
    cvt_stream(A.in[16], (bf16*)(F.ws + WS_VB), (size_t)NEXP * D / 8, gw, NGW, lane);
}

__device__ __forceinline__ unsigned okey(float v) { const unsigned u = __float_as_uint(v); return (u & 0x80000000u) ? ~u : (u | 0x80000000u); }
__device__ __forceinline__ float okey_inv(unsigned k) { const unsigned u = (k & 0x80000000u) ? (k & 0x7fffffffu) : ~k; return __uint_as_float(u); }
template <int N> __device__ __forceinline__ void bitonic_sort_desc(unsigned (&k)[N]) {
#pragma unroll
    for (int sz = 2; sz <= N; sz <<= 1)
#pragma unroll
        for (int st = sz >> 1; st > 0; st >>= 1)
#pragma unroll
            for (int i = 0; i < N; ++i) { const int l = i ^ st;
                if (l > i) { const unsigned a = k[i], b = k[l]; const unsigned mx = a > b ? a : b, mn = a > b ? b : a;
                    if ((i & sz) == 0) { k[i] = mx; k[l] = mn; } else { k[i] = mn; k[l] = mx; } } }
}
template <int N> __device__ __forceinline__ void bitonic_merge_desc(unsigned (&k)[N]) {
#pragma unroll
    for (int st = N >> 1; st > 0; st >>= 1)
#pragma unroll
        for (int i = 0; i < N; ++i) { const int l = i ^ st;
            if (l > i) { const unsigned a = k[i], b = k[l]; k[i] = a > b ? a : b; k[l] = a > b ? b : a; } }
}
__device__ __forceinline__ void pair_merge16(unsigned (&k)[16]) {
    unsigned c[16];
#pragma unroll
    for (int i = 0; i < 16; ++i) { const unsigned o = (unsigned)__shfl_xor((int)k[15 - i], 32); c[i] = k[i] > o ? k[i] : o; }
    bitonic_merge_desc<16>(c);
#pragma unroll
    for (int i = 0; i < 16; ++i) k[i] = c[i];
}
__device__ __forceinline__ void select_phase(Frame& F, const Args& A) {
    const bf16* QP = (const bf16*)(F.ws + WS_QP); const bf16* SKB = (const bf16*)(F.ws + WS_SK);
    int* IDS = (int*)(F.ws + WS_IDS); float* GG = (float*)(F.ws + WS_G);
    const int gw = F.vcu * NWAVES + F.wave, NGW = F.G * NWAVES, lane = F.lane, q31 = lane & 31, hi = lane >> 5;
    LAS unsigned* slot = (LAS unsigned*)(F.lds + F.wave * (64 * 36) + lane * 36);
    for (int task = gw; task < (M / 32) * 8; task += NGW) {
        const int tb = task >> 3, h = task & 7, tok = tb * 32 + q31;
        unsigned top[2][16];
#pragma unroll
        for (int half = 0; half < 2; ++half) {
            const bf16* qsrc = QP + (size_t)tok * 2048 + h * 256 + half * 128;
            bf16x8 Bq[8];
#pragma unroll
            for (int s = 0; s < 8; ++s) Bq[s] = *(const bf16x8*)(qsrc + 16 * s + 8 * hi);
            const bf16* sk = SKB + half * 16384;
            unsigned key[64];
#pragma unroll
            for (int kt = 0; kt < 4; ++kt) { f32x16 a;
#pragma unroll
                for (int e = 0; e < 16; ++e) a[e] = 0.f;
#pragma unroll
                for (int s = 0; s < 8; ++s) { const bf16x8 af = *(const bf16x8*)(sk + (size_t)(kt * 32 + q31) * 128 + 16 * s + 8 * hi); a = MFMA32(af, Bq[s], a); }
#pragma unroll
                for (int e = 0; e < 16; ++e) { const int idx = kt * 32 + crow(e, 0) + 4 * hi; key[kt * 16 + e] = (okey(a[e]) & ~127u) | (unsigned)(127 - idx); } }
            bitonic_sort_desc<64>(key);
#pragma unroll
            for (int i = 0; i < 16; ++i) top[half][i] = key[i];
            pair_merge16(top[half]);
        }
        float va[16], vb[16];
        unsigned iw[8];
#pragma unroll
        for (int i = 0; i < 16; ++i) { const float v1 = okey_inv(top[0][i] & ~127u), v2 = okey_inv(top[1][i] & ~127u); va[i] = hi ? v2 : v1; vb[i] = hi ? v1 : v2; }
#pragma unroll
        for (int w = 0; w < 4; ++w) { unsigned a = 0, b = 0;
#pragma unroll
            for (int e = 0; e < 4; ++e) { a |= (127u - (top[0][4 * w + e] & 127u)) << (8 * e); b |= (127u - (top[1][4 * w + e] & 127u)) << (8 * e); }
            iw[w] = a; iw[4 + w] = b; }
#pragma unroll
        for (int w = 0; w < 8; ++w) slot[w] = iw[w];
        unsigned cand[32];
        int nc = 0;
#pragma unroll
        for (int i = 0; i < 16; ++i)
#pragma unroll
            for (int j = i; j < 16; ++j) if ((i + 1) * (j + 1) <= 16) {
                const float sum = va[i] + vb[j];
                const unsigned pos = hi ? (unsigned)(j * 16 + i) : (unsigned)(i * 16 + j);
                unsigned kk = (okey(sum) & ~255u) | (255u - pos);
                if (i == j) kk = hi ? 0u : kk;
                cand[nc] = kk; ++nc; }
#pragma unroll
        for (int c = 27; c < 32; ++c) cand[c] = 0u;
        bitonic_sort_desc<32>(cand);
        unsigned fin[16];
#pragma unroll
        for (int i = 0; i < 16; ++i) fin[i] = cand[i];
        pair_merge16(fin);
        LDS_WAIT(); asm volatile("" ::: "memory");
        const LAS unsigned char* sb = (const LAS unsigned char*)slot;
        float vals[16]; int ids[16];
#pragma unroll
        for (int k = 0; k < 16; ++k) { const unsigned pos = 255u - (fin[k] & 255u); vals[k] = okey_inv(fin[k] & ~255u);
            const int e1 = sb[pos >> 4], e2 = sb[16 + (pos & 15)]; ids[k] = e1 * 128 + e2; }
        float den = 0.f, ex[16];
#pragma unroll
        for (int k = 0; k < 16; ++k) { ex[k] = fexp2((vals[k] - vals[0]) * LOG2E); den += ex[k]; }
        const float inv = 1.0f / den;
        const size_t ob = ((size_t)tok * 8 + h) * 16;
        if (hi == 0) {
#pragma unroll
            for (int w = 0; w < 4; ++w) { v4u o; o.x = ids[4 * w]; o.y = ids[4 * w + 1]; o.z = ids[4 * w + 2]; o.w = ids[4 * w + 3]; *(v4u*)(IDS + ob + 4 * w) = o; }
        } else {
#pragma unroll
            for (int w = 0; w < 4; ++w) { f32x4 o; o.x = ex[4 * w] * inv; o.y = ex[4 * w + 1] * inv; o.z = ex[4 * w + 2] * inv; o.w = ex[4 * w + 3] * inv; *(f32x4*)(GG + ob + 4 * w) = o; }
        }
        LDS_WAIT(); asm volatile("" ::: "memory");
    }
}

__device__ __forceinline__ float dot2u(unsigned a, unsigned b, float acc) { return __builtin_amdgcn_fdot2_f32_bf16(__builtin_bit_cast(bf2_t, a), __builtin_bit_cast(bf2_t, b), acc, false); }
__device__ __forceinline__ float dot8(const v4u a, const v4u b, float acc) {
    acc = dot2u(a.x, b.x, acc); acc = dot2u(a.y, b.y, acc); acc = dot2u(a.z, b.z, acc); acc = dot2u(a.w, b.w, acc);
    return acc;
}
__device__ __forceinline__ void expert_phase(Frame& F, const Args& A) {
    const bf16* X1B = (const bf16*)(F.ws + WS_X1B); const bf16* UB = (const bf16*)(F.ws + WS_UB); const bf16* VB = (const bf16*)(F.ws + WS_VB);
    const int* IDS = (const int*)(F.ws + WS_IDS); const float* GG = (const float*)(F.ws + WS_G);
    const float* gam = A.in[17]; const float* bet = A.in[18];
    const int gw = F.vcu * NWAVES + F.wave, NGW = F.G * NWAVES, lane = F.lane;
    for (int tok = gw; tok < M; tok += NGW) {
        const v4u xa = *(const v4u*)(X1B + (size_t)tok * D + 8 * lane), xb = *(const v4u*)(X1B + (size_t)tok * D + 512 + 8 * lane);
        int idv[2]; float gv[2], av[2] = {0.f, 0.f};
        idv[0] = IDS[(size_t)tok * 128 + lane]; idv[1] = IDS[(size_t)tok * 128 + 64 + lane];
        gv[0] = GG[(size_t)tok * 128 + lane]; gv[1] = GG[(size_t)tok * 128 + 64 + lane];
#pragma unroll
        for (int hf = 0; hf < 2; ++hf)
            for (int jb = 0; jb < 8; ++jb) {
                v4u ra[8], rb[8];
#pragma unroll
                for (int k = 0; k < 8; ++k) { const int id = __builtin_amdgcn_readlane(idv[hf], jb * 8 + k); const bf16* rp = UB + (size_t)id * D + 8 * lane; ra[k] = *(const v4u*)rp; rb[k] = *(const v4u*)(rp + 512); }
#pragma unroll
                for (int k = 0; k < 8; ++k) { float d = dot8(ra[k], xa, 0.f); d = dot8(rb[k], xb, d); d = wave_sum(d); av[hf] = (lane == jb * 8 + k) ? d : av[hf]; }
            }
        float hid[2];
#pragma unroll
        for (int hf = 0; hf < 2; ++hf) hid[hf] = gelu_tanh(av[hf]) * gv[hf];
        float y[16];
#pragma unroll
        for (int e = 0; e < 16; ++e) y[e] = 0.f;
#pragma unroll
        for (int hf = 0; hf < 2; ++hf)
            for (int jb = 0; jb < 8; ++jb) {
                v4u ra[8], rb[8];
#pragma unroll
                for (int k = 0; k < 8; ++k) { const int id = __builtin_amdgcn_readlane(idv[hf], jb * 8 + k); const bf16* rp = VB + (size_t)id * D + 8 * lane; ra[k] = *(const v4u*)rp; rb[k] = *(const v4u*)(rp + 512); }
#pragma unroll
                for (int k = 0; k < 8; ++k) { const float hh = __builtin_bit_cast(float, __builtin_amdgcn_readlane(__builtin_bit_cast(int, hid[hf]), jb * 8 + k));
                    y[0] += hh * bf_lo(ra[k].x); y[1] += hh * bf_hi(ra[k].x); y[2] += hh * bf_lo(ra[k].y); y[3] += hh * bf_hi(ra[k].y);
                    y[4] += hh * bf_lo(ra[k].z); y[5] += hh * bf_hi(ra[k].z); y[6] += hh * bf_lo(ra[k].w); y[7] += hh * bf_hi(ra[k].w);
                    y[8] += hh * bf_lo(rb[k].x); y[9] += hh * bf_hi(rb[k].x); y[10] += hh * bf_lo(rb[k].y); y[11] += hh * bf_hi(rb[k].y);
                    y[12] += hh * bf_lo(rb[k].z); y[13] += hh * bf_hi(rb[k].z); y[14] += hh * bf_lo(rb[k].w); y[15] += hh * bf_hi(rb[k].w); }
            }
        float* xr = F.out + (size_t)tok * D;
        f32x4 x4[4]; x4[0] = *(const f32x4*)(xr + 8 * lane); x4[1] = *(const f32x4*)(xr + 8 * lane + 4); x4[2] = *(const f32x4*)(xr + 512 + 8 * lane); x4[3] = *(const f32x4*)(xr + 512 + 8 * lane + 4);
        float s = 0.f;
#pragma unroll
        for (int e = 0; e < 16; ++e) { y[e] += DN_ALPHA * x4[e >> 2][e & 3]; s += y[e]; }
        const float mean = wave_sum(s) * (1.f / D); float s2 = 0.f;
#pragma unroll
        for (int e = 0; e < 16; ++e) { y[e] -= mean; s2 += y[e] * y[e]; }
        const float rstd = 1.f / sqrtf(wave_sum(s2) * (1.f / D) + LN_EPS);
#pragma unroll
        for (int c = 0; c < 4; ++c) { const int col = (c >> 1) * 512 + 8 * lane + (c & 1) * 4;
            const f32x4 gg = *(const f32x4*)(gam + col), bb = *(const f32x4*)(bet + col);
            f32x4 o; o.x = y[4 * c] * rstd * gg.x + bb.x; o.y = y[4 * c + 1] * rstd * gg.y + bb.y; o.z = y[4 * c + 2] * rstd * gg.z + bb.z; o.w = y[4 * c + 3] * rstd * gg.w + bb.w;
            *(f32x4*)((A.alt ? (float*)(F.ws + WS_QP) + (size_t)tok * D : xr) + col) = o; }
    }
}
__device__ __forceinline__ void wave_argmax(float& v, int& i) {
#pragma unroll
    for (int o = 1; o < 64; o <<= 1) { const float ov = __shfl_xor(v, o); const int oi = __shfl_xor(i, o); if (ov > v || (ov == v && oi < i)) { v = ov; i = oi; } }
}
__device__ __forceinline__ void naive_select_phase(Frame& F, const Args& A) {
    const bf16* QP = (const bf16*)(F.ws + WS_QP);
    int* IDS = (int*)(F.ws + WS_IDS); float* GG = (float*)(F.ws + WS_G);
    const int gw = F.vcu * NWAVES + F.wave, NGW = F.G * NWAVES, lane = F.lane;
    for (int task = gw; task < M * 8; task += NGW) {
        const int tok = task >> 3, h = task & 7;
        float tv[2]; int ti[2];
        for (int half = 0; half < 2; ++half) {
            const float* sk = A.in[13 + half];
            const bf16* qsrc = QP + (size_t)tok * 2048 + h * 256 + half * 128;
            float s0 = 0.f, s1 = 0.f;
            for (int d = 0; d < 128; ++d) { const float qv = __uint_as_float((unsigned)qsrc[d] << 16); s0 += qv * sk[lane * 128 + d]; s1 += qv * sk[(lane + 64) * 128 + d]; }
            float keepv = 0.f; int keepi = 0;
            for (int r = 0; r < 16; ++r) {
                float bv = s0; int bi = lane; if (s1 > bv) { bv = s1; bi = lane + 64; }
                wave_argmax(bv, bi);
                if (bi == lane) s0 = -INFINITY; if (bi == lane + 64) s1 = -INFINITY;
                if (lane == r) { keepv = bv; keepi = bi; }
            }
            tv[half] = keepv; ti[half] = keepi;
        }
        float c[4];
#pragma unroll
        for (int k = 0; k < 4; ++k) { const int pos = lane + 64 * k; c[k] = __shfl(tv[0], pos >> 4) + __shfl(tv[1], pos & 15); }
        float fv = 0.f; int fp = 0;
        for (int r = 0; r < 16; ++r) {
            float bv = c[0]; int bi = lane;
#pragma unroll
            for (int k = 1; k < 4; ++k) if (c[k] > bv) { bv = c[k]; bi = lane + 64 * k; }
            wave_argmax(bv, bi);
#pragma unroll
            for (int k = 0; k < 4; ++k) if (bi == lane + 64 * k) c[k] = -INFINITY;
            if (lane == r) { fv = bv; fp = bi; }
        }
        const int e1 = __shfl(ti[0], fp >> 4), e2 = __shfl(ti[1], fp & 15);
        const float mx = __shfl(fv, 0);
        float ex = lane < 16 ? expf(fv - mx) : 0.f;
        const float den = wave_sum(ex);
        if (lane < 16) { IDS[((size_t)tok * 8 + h) * 16 + lane] = e1 * 128 + e2; GG[((size_t)tok * 8 + h) * 16 + lane] = ex / den; }
    }
}
__device__ __forceinline__ void naive_expert_phase(Frame& F, const Args& A) {
    const int* IDS = (const int*)(F.ws + WS_IDS); const float* GG = (const float*)(F.ws + WS_G);
    const float* UT = A.in[15]; const float* VT = A.in[16]; const float* gam = A.in[17]; const float* bet = A.in[18];
    const int gw = F.vcu * NWAVES + F.wave, NGW = F.G * NWAVES, lane = F.lane;
    for (int tok = gw; tok < M; tok += NGW) {
        float* xr = F.out + (size_t)tok * D;
        float x[16], y[16];
#pragma unroll
        for (int e = 0; e < 16; ++e) { x[e] = xr[lane + 64 * e]; y[e] = 0.f; }
        for (int j = 0; j < 128; ++j) {
            const int id = IDS[(size_t)tok * 128 + j]; const float g = GG[(size_t)tok * 128 + j];
            const float* ur = UT + (size_t)id * D; const float* vr = VT + (size_t)id * D;
            float d = 0.f;
#pragma unroll
            for (int e = 0; e < 16; ++e) d += x[e] * ur[lane + 64 * e];
            d = wave_sum(d);
            const float z = 0.7978845608028654f * (d + 0.044715f * d * d * d);
            const float hid = 0.5f * d * (1.0f + tanhf(z)) * g;
#pragma unroll
            for (int e = 0; e < 16; ++e) y[e] += hid * vr[lane + 64 * e];
        }
        float s = 0.f;
#pragma unroll
        for (int e = 0; e < 16; ++e) { y[e] += DN_ALPHA * x[e]; s += y[e]; }
        const float mean = wave_sum(s) * (1.f / D); float s2 = 0.f;
#pragma unroll
        for (int e = 0; e < 16; ++e) { y[e] -= mean; s2 += y[e] * y[e]; }
        const float rstd = 1.f / sqrtf(wave_sum(s2) * (1.f / D) + LN_EPS);
#pragma unroll
        for (int e = 0; e < 16; ++e) xr[lane + 64 * e] = y[e] * rstd * gam[lane + 64 * e] + bet[lane + 64 * e];
    }
}
template <int CTRL, int RM> __device__ __forceinline__ float dpp_add(float v) { const int t = __builtin_amdgcn_update_dpp(0, __float_as_int(v), CTRL, RM, 0xf, false); return v + __int_as_float(t); }
__device__ __forceinline__ float wave_total(float v) {
    v = dpp_add<0xB1, 0xf>(v);
    v = dpp_add<0x4E, 0xf>(v);
    v = dpp_add<0x141, 0xf>(v);
    v = dpp_add<0x140, 0xf>(v);
    v = dpp_add<0x142, 0xa>(v);
    v = dpp_add<0x143, 0xc>(v);
    return __int_as_float(__builtin_amdgcn_readlane(__float_as_int(v), 63));
}
#ifndef XP_NCH_
#define XP_NCH_ 32
#define XP_SHIFT_ 9
#endif
#ifndef XP_B
#define XP_B 4
#endif
#ifndef XP_NSU
#define XP_NSU 4
#endif
#ifndef XP_NSV
#define XP_NSV 2
#endif
constexpr int XP_NCH = XP_NCH_, XP_SHIFT = XP_SHIFT_;
constexpr int XP_SKP = 136, XP_STP = XP_NCH + 4;
__device__ __forceinline__ void expert_phase2(Frame& F, const Args& A) {
    const bf16* X1B = (const bf16*)(F.ws + WS_X1B); const bf16* UB = (const bf16*)(F.ws + WS_UB); const bf16* VB = (const bf16*)(F.ws + WS_VB);
    const int* IDS = (const int*)(F.ws + WS_IDS); const float* GG = (const float*)(F.ws + WS_G);
    const float* gam = A.in[17]; const float* bet = A.in[18];
    const int gw = F.vcu * NWAVES + F.wave, lane = F.lane;
    LAS unsigned* SK = (LAS unsigned*)(F.lds) + F.wave * (8 * XP_SKP);
    LAS int* ST = (LAS int*)(F.lds + 8 * 8 * XP_SKP * 4) + F.wave * (8 * XP_STP);
    const int tok0 = gw * 8;
    if (tok0 >= M) return;
#pragma unroll 1
    for (int s = 0; s < 8; ++s) {
        const int id0 = IDS[(size_t)(tok0 + s) * 128 + lane], id1 = IDS[(size_t)(tok0 + s) * 128 + 64 + lane];
        const int c0 = id0 >> XP_SHIFT, c1 = id1 >> XP_SHIFT;
        int base = 0, r0 = 0, r1 = 0, stv = 0;
#pragma unroll 1
        for (int c = 0; c < XP_NCH; ++c) {
            const unsigned long long m0 = __ballot(c0 == c), m1 = __ballot(c1 == c);
            const int n0 = __popcll(m0), n1 = __popcll(m1);
            const int p0 = __builtin_amdgcn_mbcnt_hi((unsigned)(m0 >> 32), __builtin_amdgcn_mbcnt_lo((unsigned)m0, 0));
            const int p1 = __builtin_amdgcn_mbcnt_hi((unsigned)(m1 >> 32), __builtin_amdgcn_mbcnt_lo((unsigned)m1, 0));
            if (c0 == c) r0 = base + p0;
            if (c1 == c) r1 = base + n0 + p1;
            if (lane == c) stv = base;
            base += n0 + n1;
        }
        SK[s * XP_SKP + r0] = (unsigned)id0 | ((unsigned)lane << 16);
        SK[s * XP_SKP + r1] = (unsigned)id1 | ((unsigned)(lane + 64) << 16);
        if (lane < 8) SK[s * XP_SKP + 128 + lane] = 0u;
        if (lane < XP_NCH) ST[s * XP_STP + lane] = stv;
        if (lane == 0) ST[s * XP_STP + XP_NCH] = 128;
    }
    LDS_WAIT(); asm volatile("" ::: "memory");
    v4u xa[8], xb[8];
#pragma unroll
    for (int s = 0; s < 8; ++s) { xa[s] = *(const v4u*)(X1B + (size_t)(tok0 + s) * D + 8 * lane); xb[s] = *(const v4u*)(X1B + (size_t)(tok0 + s) * D + 512 + 8 * lane); }
    float av0[8], av1[8];
#pragma unroll
    for (int s = 0; s < 8; ++s) { av0[s] = 0.f; av1[s] = 0.f; }
#pragma unroll 1
    for (int c = 0; c < XP_NCH; ++c) {
        const int sbv = ST[(lane & 7) * XP_STP + c], sev = ST[(lane & 7) * XP_STP + c + 1];
#pragma unroll
        for (int g = 0; g < 8 / XP_NSU; ++g) {
            int b[XP_NSU], e[XP_NSU]; bool more = false;
#pragma unroll
            for (int q = 0; q < XP_NSU; ++q) { b[q] = __builtin_amdgcn_readlane(sbv, g * XP_NSU + q); e[q] = __builtin_amdgcn_readlane(sev, g * XP_NSU + q); more |= b[q] < e[q]; }
            while (more) {
                int m[XP_NSU]; unsigned k[XP_NSU][XP_B]; v4u ra[XP_NSU][XP_B], rb[XP_NSU][XP_B];
#pragma unroll
                for (int q = 0; q < XP_NSU; ++q) { m[q] = min(XP_B, e[q] - b[q]);
                    const unsigned kv = SK[(g * XP_NSU + q) * XP_SKP + b[q] + (lane & (XP_B - 1))];
#pragma unroll
                    for (int i = 0; i < XP_B; ++i) { k[q][i] = (unsigned)__builtin_amdgcn_readlane((int)kv, i);
                        if (i < m[q]) { const bf16* rp = UB + (size_t)(k[q][i] & 0xffffu) * D + 8 * lane; ra[q][i] = *(const v4u*)rp; rb[q][i] = *(const v4u*)(rp + 512); } } }
                more = false;
#pragma unroll
                for (int q = 0; q < XP_NSU; ++q) { const int s = g * XP_NSU + q;
#pragma unroll
                    for (int i = 0; i < XP_B; ++i) if (i < m[q]) { float d = dot8(ra[q][i], xa[s], 0.f); d = dot8(rb[q][i], xb[s], d); const float t = wave_total(d); const int j = (int)(k[q][i] >> 16);
                        av0[s] = (lane == j) ? t : av0[s]; av1[s] = (lane + 64 == j) ? t : av1[s]; }
                    b[q] += max(m[q], 0); more |= b[q] < e[q]; }
            }
        }
    }
    float h0[8], h1[8];
#pragma unroll
    for (int s = 0; s < 8; ++s) { h0[s] = gelu_tanh(av0[s]) * GG[(size_t)(tok0 + s) * 128 + lane]; h1[s] = gelu_tanh(av1[s]) * GG[(size_t)(tok0 + s) * 128 + 64 + lane]; }
    float y[8][16];
#pragma unroll
    for (int s = 0; s < 8; ++s)
#pragma unroll
        for (int q = 0; q < 16; ++q) y[s][q] = 0.f;
#pragma unroll 1
    for (int c = 0; c < XP_NCH; ++c) {
        const int sbv = ST[(lane & 7) * XP_STP + c], sev = ST[(lane & 7) * XP_STP + c + 1];
#pragma unroll
        for (int g = 0; g < 8 / XP_NSV; ++g) {
            int b[XP_NSV], e[XP_NSV]; bool more = false;
#pragma unroll
            for (int q = 0; q < XP_NSV; ++q) { b[q] = __builtin_amdgcn_readlane(sbv, g * XP_NSV + q); e[q] = __builtin_amdgcn_readlane(sev, g * XP_NSV + q); more |= b[q] < e[q]; }
            while (more) {
                int m[XP_NSV]; unsigned k[XP_NSV][XP_B]; v4u ra[XP_NSV][XP_B], rb[XP_NSV][XP_B];
#pragma unroll
                for (int q = 0; q < XP_NSV; ++q) { m[q] = min(XP_B, e[q] - b[q]);
                    const unsigned kv = SK[(g * XP_NSV + q) * XP_SKP + b[q] + (lane & (XP_B - 1))];
#pragma unroll
                    for (int i = 0; i < XP_B; ++i) { k[q][i] = (unsigned)__builtin_amdgcn_readlane((int)kv, i);
                        if (i < m[q]) { const bf16* rp = VB + (size_t)(k[q][i] & 0xffffu) * D + 8 * lane; ra[q][i] = *(const v4u*)rp; rb[q][i] = *(const v4u*)(rp + 512); } } }
                more = false;
#pragma unroll
                for (int q = 0; q < XP_NSV; ++q) { const int s = g * XP_NSV + q;
#pragma unroll
                    for (int i = 0; i < XP_B; ++i) if (i < m[q]) { const int j = (int)(k[q][i] >> 16);
                        const int ha = __builtin_amdgcn_readlane(__float_as_int(h0[s]), j & 63), hb = __builtin_amdgcn_readlane(__float_as_int(h1[s]), j & 63);
                        const float hh = __int_as_float(j < 64 ? ha : hb);
                        y[s][0] += hh * bf_lo(ra[q][i].x); y[s][1] += hh * bf_hi(ra[q][i].x); y[s][2] += hh * bf_lo(ra[q][i].y); y[s][3] += hh * bf_hi(ra[q][i].y);
                        y[s][4] += hh * bf_lo(ra[q][i].z); y[s][5] += hh * bf_hi(ra[q][i].z); y[s][6] += hh * bf_lo(ra[q][i].w); y[s][7] += hh * bf_hi(ra[q][i].w);
                        y[s][8] += hh * bf_lo(rb[q][i].x); y[s][9] += hh * bf_hi(rb[q][i].x); y[s][10] += hh * bf_lo(rb[q][i].y); y[s][11] += hh * bf_hi(rb[q][i].y);
                        y[s][12] += hh * bf_lo(rb[q][i].z); y[s][13] += hh * bf_hi(rb[q][i].z); y[s][14] += hh * bf_lo(rb[q][i].w); y[s][15] += hh * bf_hi(rb[q][i].w); }
                    b[q] += max(m[q], 0); more |= b[q] < e[q]; }
            }
        }
    }
#pragma unroll
    for (int s = 0; s < 8; ++s) {
        float* xr = F.out + (size_t)(tok0 + s) * D;
        f32x4 x4[4]; x4[0] = *(const f32x4*)(xr + 8 * lane); x4[1] = *(const f32x4*)(xr + 8 * lane + 4); x4[2] = *(const f32x4*)(xr + 512 + 8 * lane); x4[3] = *(const f32x4*)(xr + 512 + 8 * lane + 4);
        float sm = 0.f;
#pragma unroll
        for (int q = 0; q < 16; ++q) { y[s][q] += DN_ALPHA * x4[q >> 2][q & 3]; sm += y[s][q]; }
        const float mean = wave_sum(sm) * (1.f / D); float s2 = 0.f;
#pragma unroll
        for (int q = 0; q < 16; ++q) { y[s][q] -= mean; s2 += y[s][q] * y[s][q]; }
        const float rstd = 1.f / sqrtf(wave_sum(s2) * (1.f / D) + LN_EPS);
#pragma unroll
        for (int cc = 0; cc < 4; ++cc) { const int col = (cc >> 1) * 512 + 8 * lane + (cc & 1) * 4;
            const f32x4 gg = *(const f32x4*)(gam + col), bb = *(const f32x4*)(bet + col);
            f32x4 o; o.x = y[s][4 * cc] * rstd * gg.x + bb.x; o.y = y[s][4 * cc + 1] * rstd * gg.y + bb.y; o.z = y[s][4 * cc + 2] * rstd * gg.z + bb.z; o.w = y[s][4 * cc + 3] * rstd * gg.w + bb.w;
            *(f32x4*)((A.alt ? (float*)(F.ws + WS_QP) + (size_t)(tok0 + s) * D : xr) + col) = o; }
    }
}
#ifndef XP_SYNC
#define XP_SYNC 8
#endif
constexpr int X3_SKP = 136;
constexpr int X3_LDS_SK = 0, X3_LDS_SCHED = 8 * 8 * X3_SKP * 4, X3_LDS_A = X3_LDS_SCHED + 8 * 256 * 4, X3_LDS_END = X3_LDS_A + 8 * 8 * 128 * 4;
static_assert(X3_LDS_END <= RING_BYTES, "expert phase LDS");
__device__ __forceinline__ float wave_total_row3(float v) {
    v = dpp_add<0xB1, 0xf>(v); v = dpp_add<0x4E, 0xf>(v); v = dpp_add<0x141, 0xf>(v); v = dpp_add<0x140, 0xf>(v); v = dpp_add<0x142, 0xa>(v); v = dpp_add<0x143, 0xc>(v);
    return v;
}
__device__ __forceinline__ void expert_phase3(Frame& F, const Args& A) {
    const bf16* X1B = (const bf16*)(F.ws + WS_X1B); const bf16* UB = (const bf16*)(F.ws + WS_UB); const bf16* VB = (const bf16*)(F.ws + WS_VB);
    const int* IDS = (const int*)(F.ws + WS_IDS); const float* GG = (const float*)(F.ws + WS_G);
    const float* gam = A.in[17]; const float* bet = A.in[18];
    const int gw = F.vcu * NWAVES + F.wave, lane = F.lane;
    LAS unsigned* SK = (LAS unsigned*)(F.lds + X3_LDS_SK) + F.wave * (8 * X3_SKP);
    LAS unsigned* SCHED = (LAS unsigned*)(F.lds + X3_LDS_SCHED) + F.wave * 256;
    LAS float* AL = (LAS float*)(F.lds + X3_LDS_A) + F.wave * (8 * 128);
    const int tok0 = gw * 8; const unsigned lane16 = (unsigned)lane * 16u; const unsigned idmask = A.alt ? 0x1ffu : 0xffffu;
    if (tok0 >= M) return;
#pragma unroll 1
    for (int s = 0; s < 8; ++s) {
        const int id0 = IDS[(size_t)(tok0 + s) * 128 + lane], id1 = IDS[(size_t)(tok0 + s) * 128 + 64 + lane];
        const int c0 = id0 >> XP_SHIFT, c1 = id1 >> XP_SHIFT;
        int base = 0, r0 = 0, r1 = 0;
#pragma unroll 1
        for (int c = 0; c < XP_NCH; ++c) {
            const unsigned long long m0 = __ballot(c0 == c), m1 = __ballot(c1 == c);
            const int n0 = __popcll(m0), n1 = __popcll(m1);
            const int p0 = __builtin_amdgcn_mbcnt_hi((unsigned)(m0 >> 32), __builtin_amdgcn_mbcnt_lo((unsigned)m0, 0));
            const int p1 = __builtin_amdgcn_mbcnt_hi((unsigned)(m1 >> 32), __builtin_amdgcn_mbcnt_lo((unsigned)m1, 0));
            if (c0 == c) r0 = base + p0;
            if (c1 == c) r1 = base + n0 + p1;
            base += n0 + n1;
        }
        SK[s * X3_SKP + r0] = (unsigned)id0 | ((unsigned)lane << 16);
        SK[s * X3_SKP + r1] = (unsigned)id1 | ((unsigned)(lane + 64) << 16);
    }
    LDS_WAIT(); asm volatile("" ::: "memory");
    {
        int cb[4];
#pragma unroll
        for (int r = 0; r < 4; ++r) { const int n = r * 64 + lane; cb[r] = (int)((SK[(n >> 5) * X3_SKP + 4 * (n & 31)] & 0xffffu) >> XP_SHIFT); }
        int base = 0, pos[4] = {0, 0, 0, 0};
#pragma unroll
        for (int hf = 0; hf < 2; ++hf) {
#pragma unroll 1
            for (int c = 0; c < XP_NCH; ++c) {
#pragma unroll
                for (int r = 2 * hf; r < 2 * hf + 2; ++r) { const unsigned long long mm = __ballot(cb[r] == c);
                    const int pp = __builtin_amdgcn_mbcnt_hi((unsigned)(mm >> 32), __builtin_amdgcn_mbcnt_lo((unsigned)mm, 0));
                    if (cb[r] == c) pos[r] = base + pp;
                    base += __popcll(mm); }
            }
        }
#pragma unroll
        for (int r = 0; r < 4; ++r) SCHED[pos[r]] = (unsigned)(r * 64 + lane);
    }
    LDS_WAIT(); asm volatile("" ::: "memory");
#define X3_ISSUE(RA, RB, K, SL, t, TAB) do { const int n_ = __builtin_amdgcn_readfirstlane((int)SCHED[(t) < 256 ? (t) : 255]); SL = n_ >> 5; \
        const unsigned kv_ = SK[(n_ >> 5) * X3_SKP + 4 * (n_ & 31) + (lane & 3)]; \
        _Pragma("unroll") for (int i = 0; i < 4; ++i) { K[i] = (unsigned)__builtin_amdgcn_readlane((int)kv_, i); const char* rp_ = (const char*)(TAB) + (size_t)(K[i] & idmask) * (D * 2); \
            RA[i] = *(const v4u*)(rp_ + lane16); RB[i] = *(const v4u*)(rp_ + 1024 + lane16); } } while (0)
#pragma unroll 1
    for (int hf = 0; hf < 2; ++hf) {
        v4u xa[4], xb[4];
#pragma unroll
        for (int s = 0; s < 4; ++s) { xa[s] = *(const v4u*)(X1B + (size_t)(tok0 + 4 * hf + s) * D + 8 * lane); xb[s] = *(const v4u*)(X1B + (size_t)(tok0 + 4 * hf + s) * D + 512 + 8 * lane); }
#define X3_UCONS(RA, RB, K, SL) do { v4u xsa = xa[0], xsb = xb[0]; \
        _Pragma("unroll") for (int s = 1; s < 4; ++s) { const bool is_ = ((SL) & 3) == s; xsa.x = is_ ? xa[s].x : xsa.x; xsa.y = is_ ? xa[s].y : xsa.y; xsa.z = is_ ? xa[s].z : xsa.z; xsa.w = is_ ? xa[s].w : xsa.w; \
            xsb.x = is_ ? xb[s].x : xsb.x; xsb.y = is_ ? xb[s].y : xsb.y; xsb.z = is_ ? xb[s].z : xsb.z; xsb.w = is_ ? xb[s].w : xsb.w; } \
        _Pragma("unroll") for (int i = 0; i < 4; ++i) { float d = dot8(RA[i], xsa, 0.f); d = dot8(RB[i], xsb, d); d = wave_total_row3(d); \
            if (lane == 63) AL[(SL) * 128 + (int)(K[i] >> 16)] = d; } } while (0)
        v4u ra0[4], rb0[4], ra1[4], rb1[4]; unsigned k0[4], k1[4]; int s0, s1;
        const int tb = 128 * hf;
        X3_ISSUE(ra0, rb0, k0, s0, tb, UB);
#pragma unroll 1
        for (int t = tb; t < tb + 128; t += 2) {
            if ((t & (XP_SYNC - 1)) == 0) __builtin_amdgcn_s_barrier();
            X3_ISSUE(ra1, rb1, k1, s1, t + 1, UB); asm volatile("" ::: "memory");
            X3_UCONS(ra0, rb0, k0, s0);
            X3_ISSUE(ra0, rb0, k0, s0, t + 2, UB); asm volatile("" ::: "memory");
            X3_UCONS(ra1, rb1, k1, s1);
        }
    }
    LDS_WAIT(); asm volatile("" ::: "memory");
#pragma unroll
    for (int s = 0; s < 8; ++s) { const float a0 = AL[s * 128 + lane], a1 = AL[s * 128 + 64 + lane];
        AL[s * 128 + lane] = gelu_tanh(a0) * GG[(size_t)(tok0 + s) * 128 + lane]; AL[s * 128 + 64 + lane] = gelu_tanh(a1) * GG[(size_t)(tok0 + s) * 128 + 64 + lane]; }
    LDS_WAIT(); asm volatile("" ::: "memory");
#pragma unroll 1
    for (int hf = 0; hf < 2; ++hf) {
        float y[4][16];
#pragma unroll
        for (int s = 0; s < 4; ++s)
#pragma unroll
            for (int q = 0; q < 16; ++q) y[s][q] = 0.f;
#define X3_VCONS(RA, RB, K, SL) do { float yp[16]; \
        _Pragma("unroll") for (int q = 0; q < 16; ++q) yp[q] = 0.f; \
        _Pragma("unroll") for (int i = 0; i < 4; ++i) { const float hh = AL[(SL) * 128 + (int)(K[i] >> 16)]; \
            yp[0] += hh * bf_lo(RA[i].x); yp[1] += hh * bf_hi(RA[i].x); yp[2] += hh * bf_lo(RA[i].y); yp[3] += hh * bf_hi(RA[i].y); \
            yp[4] += hh * bf_lo(RA[i].z); yp[5] += hh * bf_hi(RA[i].z); yp[6] += hh * bf_lo(RA[i].w); yp[7] += hh * bf_hi(RA[i].w); \
            yp[8] += hh * bf_lo(RB[i].x); yp[9] += hh * bf_hi(RB[i].x); yp[10] += hh * bf_lo(RB[i].y); yp[11] += hh * bf_hi(RB[i].y); \
            yp[12] += hh * bf_lo(RB[i].z); yp[13] += hh * bf_hi(RB[i].z); yp[14] += hh * bf_lo(RB[i].w); yp[15] += hh * bf_hi(RB[i].w); } \
        switch ((SL) & 3) { \
            case 0: _Pragma("unroll") for (int q = 0; q < 16; ++q) y[0][q] += yp[q]; break; case 1: _Pragma("unroll") for (int q = 0; q < 16; ++q) y[1][q] += yp[q]; break; \
            case 2: _Pragma("unroll") for (int q = 0; q < 16; ++q) y[2][q] += yp[q]; break; default: _Pragma("unroll") for (int q = 0; q < 16; ++q) y[3][q] += yp[q]; break; } } while (0)
        {
            v4u ra0[4], rb0[4], ra1[4], rb1[4]; unsigned k0[4], k1[4]; int s0, s1;
            const int tb = 128 * hf;
            X3_ISSUE(ra0, rb0, k0, s0, tb, VB);
#pragma unroll 1
            for (int t = tb; t < tb + 128; t += 2) {
                if ((t & (XP_SYNC - 1)) == 0) __builtin_amdgcn_s_barrier();
                X3_ISSUE(ra1, rb1, k1, s1, t + 1, VB); asm volatile("" ::: "memory");
                X3_VCONS(ra0, rb0, k0, s0);
                X3_ISSUE(ra0, rb0, k0, s0, t + 2, VB); asm volatile("" ::: "memory");
                X3_VCONS(ra1, rb1, k1, s1);
            }
        }
#pragma unroll
        for (int s = 0; s < 4; ++s) {
            float* xr = F.out + (size_t)(tok0 + 4 * hf + s) * D;
            f32x4 x4[4]; x4[0] = *(const f32x4*)(xr + 8 * lane); x4[1] = *(const f32x4*)(xr + 8 * lane + 4); x4[2] = *(const f32x4*)(xr + 512 + 8 * lane); x4[3] = *(const f32x4*)(xr + 512 + 8 * lane + 4);
            float sm = 0.f;
#pragma unroll
            for (int q = 0; q < 16; ++q) { y[s][q] += DN_ALPHA * x4[q >> 2][q & 3]; sm += y[s][q]; }
            const float mean = wave_sum(sm) * (1.f / D); float s2 = 0.f;
#pragma unroll
            for (int q = 0; q < 16; ++q) { y[s][q] -= mean; s2 += y[s][q] * y[s][q]; }
            const float rstd = 1.f / sqrtf(wave_sum(s2) * (1.f / D) + LN_EPS);
#pragma unroll
            for (int cc = 0; cc < 4; ++cc) { const int col = (cc >> 1) * 512 + 8 * lane + (cc & 1) * 4;
                const f32x4 gg = *(const f32x4*)(gam + col), bb = *(const f32x4*)(bet + col);
                f32x4 o; o.x = y[s][4 * cc] * rstd * gg.x + bb.x; o.y = y[s][4 * cc + 1] * rstd * gg.y + bb.y; o.z = y[s][4 * cc + 2] * rstd * gg.z + bb.z; o.w = y[s][4 * cc + 3] * rstd * gg.w + bb.w;
                *(f32x4*)((A.alt ? (float*)(F.ws + WS_QP) + (size_t)(tok0 + 4 * hf + s) * D : xr) + col) = o; }
        }
    }
#undef X3_ISSUE
#undef X3_UCONS
#undef X3_VCONS
}
constexpr int N_PHASES = 9;
#ifndef MK_N_LAUNCHES
#define MK_N_LAUNCHES 1
#endif

__global__ void __launch_bounds__(NWAVES * 64, 2) fwd_megakernel(Args args) {
    extern __shared__ __attribute__((aligned(16))) unsigned char lds[];
    Frame F;
    F.lds = (LAS unsigned char*)lds;
    F.tid = threadIdx.x; F.lane = F.tid & 63; F.wave = __builtin_amdgcn_readfirstlane(F.tid >> 6);
    F.G = gridDim.x; { const int bx = blockIdx.x; F.vcu = (F.G % 8 == 0) ? (bx % 8) * (F.G / 8) + bx / 8 : bx; }
    F.out = args.out; F.ws = args.ws;
    const int lo = args.ph_lo, hi = args.ph_hi;
    cg::grid_group grid = cg::this_grid();
#ifndef PHASE_MASK
#define PHASE_MASK 0x1ff
#endif
#define IN(k) (((PHASE_MASK >> (k)) & 1) && lo <= (k) && (k) < hi)
#define SEAM(k) do { if (IN(k) && IN((k) + 1)) grid.sync(); } while (0)
    typedef pg8::bf16_t b16;

    if (IN(0)) { p0_prologue(F, args); } SEAM(0);
    if (IN(1)) {
        pg8::Gemm g{(const b16*)(F.ws + WS_XB), (const b16*)(F.ws + WS_WIN), M, INC, D}; pg8::StaticOrder S; S.init(M, INC, F.G, (int)blockIdx.x);
        pg8::EpiProj E{(b16*)(F.ws + WS_PROJ)};
        pg8::gemm_phase<pg8::EpiProj, pg8::StaticOrder, true, true>(F.lds, g, S, E);
    } SEAM(1);
    if (IN(2)) { na_phase(F, args); __syncthreads(); sgu_phase(F, args); } SEAM(2);
    if (IN(3)) {
        pg8::Gemm g{(const b16*)(F.ws + WS_YCAT), (const b16*)(F.ws + WS_WCAT), M, D, D}; pg8::StaticOrder S; S.init(M, D, F.G, (int)blockIdx.x);
        pg8::EpiMerge E{(const b16*)(F.ws + WS_PROJ) + C_GA, (const b16*)(F.ws + WS_PROJ) + C_GB, (b16*)(F.ws + WS_XB)};
        pg8::gemm_phase<pg8::EpiMerge, pg8::StaticOrder, true, true>(F.lds, g, S, E);
    } SEAM(3);
    if (IN(4)) {
        pg8::Gemm g{(const b16*)(F.ws + WS_XB), (const b16*)(F.ws + WS_WOUT), M, D, D}; pg8::StaticOrder S; S.init(M, D, F.G, (int)blockIdx.x);
        pg8::EpiResF32 E{args.in[0], F.out};
        pg8::gemm_phase<pg8::EpiResF32, pg8::StaticOrder, true, true>(F.lds, g, S, E);
    } SEAM(4);
    if (IN(5)) { ln1_phase(F, args); } SEAM(5);
    if (IN(6)) {
        pg8::Gemm g{(const b16*)(F.ws + WS_X1B), (const b16*)(F.ws + WS_WQ), M, 2048, D}; pg8::StaticOrder S; S.init(M, 2048, F.G, (int)blockIdx.x);
        pg8::EpiPlain E{(b16*)(F.ws + WS_QP), 2048};
        pg8::gemm_phase<pg8::EpiPlain, pg8::StaticOrder, true, true>(F.lds, g, S, E);
    } SEAM(6);
    #ifdef NAIVE_SELECT
    if (IN(7)) { naive_select_phase(F, args); } SEAM(7);
#else
    if (IN(7)) { select_phase(F, args); } SEAM(7);
#endif
    #ifdef NAIVE_EXPERT
    if (IN(8)) { naive_expert_phase(F, args); }
#else
#ifdef EXPERT_V1
    if (IN(8)) { expert_phase(F, args); }
#else
#ifdef EXPERT_V2
    if (IN(8)) { expert_phase2(F, args); }
#else
    if (IN(8)) { expert_phase3(F, args); }
#endif
#endif
#endif
#undef IN
#undef SEAM
}

extern "C" void kernel_launch(void* const* d_in, const int* in_sizes, int n_in, void* d_out, int out_size, void* d_ws, size_t ws_size, hipStream_t stream) {
    static int grid = 0;
    if (grid == 0) {
        if (n_in != 19 || in_sizes[0] != M * D || out_size != M * D || ws_size < WS_END) { fprintf(stderr, "kernel_launch: unexpected shapes (n_in %d, in0 %d, out %d, ws %zu); nothing launched\n", n_in, n_in > 0 ? in_sizes[0] : -1, out_size, ws_size); grid = -1; return; }
        int dev = 0, cus = 0, per_cu = 0;
        if (hipGetDevice(&dev) != hipSuccess || hipDeviceGetAttribute(&cus, hipDeviceAttributeMultiprocessorCount, dev) != hipSuccess) { grid = -1; return; }
        if (hipFuncSetAttribute((const void*)fwd_megakernel, hipFuncAttributeMaxDynamicSharedMemorySize, LDS_BYTES) != hipSuccess) { fprintf(stderr, "kernel_launch: hipFuncSetAttribute failed\n"); grid = -1; return; }
        if (hipOccupancyMaxActiveBlocksPerMultiprocessor(&per_cu, (const void*)fwd_megakernel, NWAVES * 64, LDS_BYTES) != hipSuccess || per_cu < 1) { fprintf(stderr, "kernel_launch: occupancy query says %d blocks per CU\n", per_cu); grid = -1; return; }
        (void)hipGetLastError();
        grid = cus;
    }
    if (grid < 0) return;
    Args a{};
    for (int i = 0; i < 19; ++i) a.in[i] = (const float*)d_in[i];
    a.out = (float*)d_out; a.ws = (unsigned char*)d_ws;
    if (MK_N_LAUNCHES == 1) {
        a.ph_lo = 0; a.ph_hi = N_PHASES;
        void* kargs[] = {&a};
        const hipError_t e = hipLaunchCooperativeKernel((const void*)fwd_megakernel, dim3(grid), dim3(NWAVES * 64), kargs, LDS_BYTES, stream);
        if (e != hipSuccess) fprintf(stderr, "kernel_launch: cooperative launch failed: %s (grid %d)\n", hipGetErrorString(e), grid);
    } else {
#ifndef DUP_MASK
#define DUP_MASK 0
#endif
        for (int p = 0, rep = 0; p < N_PHASES; ++p) { a.ph_lo = p; a.ph_hi = p + 1;
            a.alt = (((DUP_MASK >> p) & 1) && rep == 0) ? 1 : 0;
            if (((DUP_MASK >> p) & 1) && rep == 0) { rep = 1; --p; } else rep = 0;
            hipLaunchKernelGGL(fwd_megakernel, dim3(grid), dim3(NWAVES * 64), LDS_BYTES, stream, a);
            const hipError_t le = hipPeekAtLastError(); if (le != hipSuccess) { fprintf(stderr, "kernel_launch: launch %d failed: %s\n", p, hipGetErrorName(le)); break; } }
    }
}
```
